# Optimizing an MI355X kernel written in HIP

```python
import math
import jax, jax.numpy as jnp
from jax import lax
import numpy as np

D_MODEL = 2048
BATCH = 4
SEQ = 4096
DEPTH = 2

HEAD_DIM = 128
N_HEADS = D_MODEL // HEAD_DIM
A_Q_HEADS = 6
A_KV_HEADS = 2
CMP_BLOCK = 32
CMP_STRIDE = 16
SLC_BLOCK = 64
SLC_TOPK = 16
NSA_WINDOW = 512
SLC_Q_CHUNK = 64
FORCED_SCORE = 1.0e4
B_Q_HEADS = 4
B_KV_HEADS = 2
SWA_WINDOW = 128
DIL_PAIRS = ((128, 1), (512, 4), (2048, 16))
C_HEADS_PER_PAIR = 2
C_Q_HEADS = C_HEADS_PER_PAIR * len(DIL_PAIRS)
C_KV_HEADS = len(DIL_PAIRS)
REL_BUCKETS = 32
REL_MAX_EXACT = 16
REL_MAX_DIST = 2048
BAND_BLOCK = 128
SCALE = HEAD_DIM ** -0.5
N_QK_NORMS = 8
D_FF = -(-8 * D_MODEL // (3 * 256)) * 256
SPLIT_SIZES = ((A_Q_HEADS * HEAD_DIM,) + (A_KV_HEADS * HEAD_DIM,) * 6 + (A_Q_HEADS * 3,)
               + (B_Q_HEADS * HEAD_DIM, B_KV_HEADS * HEAD_DIM, B_KV_HEADS * HEAD_DIM)
               + (C_Q_HEADS * HEAD_DIM, C_KV_HEADS * HEAD_DIM, C_KV_HEADS * HEAD_DIM))
N_IN = sum(SPLIT_SIZES)

kernel_name = "hybrid_nsa_swa_sink_dilated_block"


def rms_norm(x, g, eps=1e-6):
    xf = x.astype(jnp.float32)
    y = xf * lax.rsqrt(jnp.mean(xf * xf, axis=-1, keepdims=True) + eps)
    return (y * g.astype(jnp.float32)).astype(x.dtype)


def rel_bucket(dist):
    dist = jnp.maximum(dist, 0)
    far = jnp.maximum(dist, REL_MAX_EXACT).astype(jnp.float32)
    log_b = REL_MAX_EXACT + (jnp.log(far / REL_MAX_EXACT) / math.log(REL_MAX_DIST / REL_MAX_EXACT)
                             * (REL_BUCKETS - REL_MAX_EXACT)).astype(jnp.int32)
    log_b = jnp.minimum(log_b, REL_BUCKETS - 1)
    return jnp.where(dist < REL_MAX_EXACT, dist, log_b)


def banded_attention(q, k, v, head_bias, max_dist, dist_scale=1, sinks=None):
    n, L, hq, hd = q.shape
    hk = k.shape[2]
    grp = hq // hk
    nb = -(-L // BAND_BLOCK)
    Lp = nb * BAND_BLOCK
    n_prev = -(-max_dist // BAND_BLOCK)
    W = (n_prev + 1) * BAND_BLOCK
    pad_end = Lp - L
    qb = jnp.pad(q, ((0, 0), (0, pad_end), (0, 0), (0, 0))).reshape(n, nb, BAND_BLOCK, hk, grp, hd)
    kv_pad = ((0, 0), (n_prev * BAND_BLOCK, pad_end), (0, 0), (0, 0))
    kb = jnp.pad(k, kv_pad).reshape(n, nb + n_prev, BAND_BLOCK, hk, hd)
    vb = jnp.pad(v, kv_pad).reshape(n, nb + n_prev, BAND_BLOCK, hk, hd)
    kw = jnp.concatenate([kb[:, s:s + nb] for s in range(n_prev + 1)], axis=2)
    vw = jnp.concatenate([vb[:, s:s + nb] for s in range(n_prev + 1)], axis=2)
    qpos = jnp.arange(nb)[:, None] * BAND_BLOCK + jnp.arange(BAND_BLOCK)[None, :]
    kpos = (jnp.arange(nb)[:, None] - n_prev) * BAND_BLOCK + jnp.arange(W)[None, :]
    dist = qpos[:, :, None] - kpos[:, None, :]
    valid = (dist >= 0) & (dist <= max_dist) & (kpos[:, None, :] >= 0)
    bias = head_bias.astype(jnp.float32)[rel_bucket(dist * dist_scale)]
    bias = bias.reshape(nb, BAND_BLOCK, W, hk, grp).transpose(0, 3, 4, 1, 2)
    s = jnp.einsum('nbqkgd,nbckd->nbkgqc', qb, kw, preferred_element_type=jnp.float32) * SCALE + bias
    s = jnp.where(valid[:, None, None], s, -jnp.inf)
    lse = jax.nn.logsumexp(s, axis=-1)
    if sinks is None:
        total = lse
    else:
        total = jnp.logaddexp(lse, sinks.astype(jnp.float32).reshape(1, 1, hk, grp, 1))
    p = jnp.exp(s - total[..., None])
    out = jnp.einsum('nbkgqc,nbckd->nbqkgd', p.astype(v.dtype), vw).reshape(n, Lp, hq, hd)[:, :L]
    lse = lse.transpose(0, 1, 4, 2, 3).reshape(n, Lp, hq)[:, :L]
    return out.astype(q.dtype), lse


def nsa_compress(x, pe, w1, w2):
    B, T, hk, hd = x.shape
    n_cmp = (T - CMP_BLOCK) // CMP_STRIDE + 1
    tok = jnp.arange(n_cmp)[:, None] * CMP_STRIDE + jnp.arange(CMP_BLOCK)[None, :]
    blk = x[:, tok] + pe[:, None, :].astype(x.dtype)
    blk = blk.transpose(0, 1, 3, 2, 4).reshape(B, n_cmp, hk, CMP_BLOCK * hd)
    return jax.nn.gelu(blk @ w1) @ w2


def nsa_mixer(q, k_cmp, v_cmp, k_slc, v_slc, k_win, v_win, gates, k_cmp_gain, cmp_pe, cmp_w1, cmp_w2, head_bias):
    B, T, hq, hd = q.shape
    hk = k_cmp.shape[2]
    grp = hq // hk
    qg = q.reshape(B, T, hk, grp, hd)
    t_pos = jnp.arange(T)
    kc = rms_norm(nsa_compress(k_cmp, cmp_pe[0], cmp_w1[0], cmp_w2[0]), k_cmp_gain)
    vc = nsa_compress(v_cmp, cmp_pe[1], cmp_w1[1], cmp_w2[1])
    n_cmp = kc.shape[1]
    c_end = jnp.arange(n_cmp) * CMP_STRIDE + CMP_BLOCK - 1
    dist_c = t_pos[:, None] - c_end[None, :]
    bias_c = head_bias.astype(jnp.float32)[rel_bucket(dist_c)].transpose(2, 0, 1).reshape(hk, grp, T, n_cmp)
    s_c = jnp.einsum('btkgd,bnkd->bkgtn', qg, kc, preferred_element_type=jnp.float32) * SCALE + bias_c
    s_c = jnp.where(dist_c >= 0, s_c, -jnp.inf)
    m = jnp.max(s_c, axis=-1, keepdims=True)
    e = jnp.exp(s_c - jnp.where(jnp.isfinite(m), m, 0.0))
    den = jnp.sum(e, axis=-1, keepdims=True)
    p_c = e / jnp.where(den > 0, den, 1.0)
    o_cmp = jnp.einsum('bkgtn,bnkd->btkgd', p_c, vc.astype(jnp.float32)).reshape(B, T, hq, hd)
    n_slc = T // SLC_BLOCK
    k_sel = min(SLC_TOPK, n_slc)
    c0 = np.arange(n_cmp)[:, None] * CMP_STRIDE
    s0 = np.arange(n_slc)[None, :] * SLC_BLOCK
    overlap = np.clip(np.minimum(c0 + CMP_BLOCK, s0 + SLC_BLOCK) - np.maximum(c0, s0), 0, None) / CMP_BLOCK
    imp = jnp.einsum('bkgtn,nj->bktj', p_c, jnp.asarray(overlap, dtype=jnp.float32))
    blk_id = jnp.arange(n_slc)[None, :]
    cur = (t_pos // SLC_BLOCK)[:, None]
    forced = (blk_id == 0) | (blk_id == cur) | (blk_id == cur - 1)
    causal_blk = blk_id * SLC_BLOCK <= t_pos[:, None]
    imp = jnp.where(causal_blk, jnp.where(forced, FORCED_SCORE, imp), -jnp.inf)
    _, idx = lax.top_k(imp, k_sel)
    kb = k_slc.reshape(B, n_slc, SLC_BLOCK, hk, hd).transpose(0, 3, 1, 2, 4)
    vb = v_slc.reshape(B, n_slc, SLC_BLOCK, hk, hd).transpose(0, 3, 1, 2, 4)
    n_chunk = T // SLC_Q_CHUNK
    q_ch = qg.reshape(B, n_chunk, SLC_Q_CHUNK, hk, grp, hd).transpose(1, 0, 3, 2, 4, 5)
    idx_ch = idx.reshape(B, hk, n_chunk, SLC_Q_CHUNK, k_sel).transpose(2, 0, 1, 3, 4)
    starts = jnp.arange(n_chunk) * SLC_Q_CHUNK
    bi = jnp.arange(B)[:, None, None, None]
    ki = jnp.arange(hk)[None, :, None, None]
    hb = head_bias.astype(jnp.float32).reshape(REL_BUCKETS, hk, grp).transpose(1, 0, 2)

    def chunk_fn(args):
        qc, ic, t0 = args
        kg = kb[bi, ki, ic]
        vg = vb[bi, ki, ic]
        tq = t0 + jnp.arange(SLC_Q_CHUNK)
        kpos = ic[..., None] * SLC_BLOCK + jnp.arange(SLC_BLOCK)
        dist = tq[None, None, :, None, None] - kpos
        bias = hb[ki[..., None], rel_bucket(dist)].transpose(0, 1, 2, 5, 3, 4)
        s = jnp.einsum('bkqgd,bkqjpd->bkqgjp', qc, kg, preferred_element_type=jnp.float32) * SCALE + bias
        s = jnp.where(dist[:, :, :, None] >= 0, s, -jnp.inf)
        p = jax.nn.softmax(s.reshape(s.shape[:4] + (k_sel * SLC_BLOCK,)), axis=-1).reshape(s.shape)
        return jnp.einsum('bkqgjp,bkqjpd->bkqgd', p.astype(vg.dtype), vg)

    o_slc = lax.map(chunk_fn, (q_ch, idx_ch, starts))
    o_slc = o_slc.transpose(1, 0, 3, 2, 4, 5).reshape(B, T, hq, hd)
    o_win, _ = banded_attention(q, k_win, v_win, head_bias, NSA_WINDOW - 1)
    g = jax.nn.sigmoid(gates.astype(jnp.float32))
    o = (g[..., 0:1] * o_cmp + g[..., 1:2] * o_slc.astype(jnp.float32) + g[..., 2:3] * o_win.astype(jnp.float32))
    return o.astype(q.dtype)


def strided_window_attention(q, k, v, head_bias, window, dilation):
    B, T, hq, hd = q.shape
    Tp = -(-T // dilation) * dilation
    Ls = Tp // dilation

    def to_sub(t):
        t = jnp.pad(t, ((0, 0), (0, Tp - T), (0, 0), (0, 0)))
        h = t.shape[2]
        return t.reshape(B, Ls, dilation, h, hd).transpose(0, 2, 1, 3, 4).reshape(B * dilation, Ls, h, hd)

    o, lse = banded_attention(to_sub(q), to_sub(k), to_sub(v), head_bias, window // dilation, dist_scale=dilation)
    o = o.reshape(B, dilation, Ls, hq, hd).transpose(0, 2, 1, 3, 4).reshape(B, Tp, hq, hd)[:, :T]
    lse = lse.reshape(B, dilation, Ls, hq).transpose(0, 2, 1, 3).reshape(B, Tp, hq)[:, :T]
    return o, lse


def dilated_mixer(q, k, v, head_bias):
    B, T, _, hd = q.shape
    outs, lses = [], []
    for g, (w, d) in enumerate(DIL_PAIRS):
        sl = slice(g * C_HEADS_PER_PAIR, (g + 1) * C_HEADS_PER_PAIR)
        o, lse = strided_window_attention(q[:, :, sl], k[:, :, g:g + 1], v[:, :, g:g + 1], head_bias[:, sl], w, d)
        outs.append(o)
        lses.append(lse)
    alpha = jax.nn.softmax(jnp.stack(lses, axis=2), axis=2)
    o = jnp.stack(outs, axis=2).astype(jnp.float32) * alpha[..., None]
    return o.reshape(B, T, C_Q_HEADS, hd).astype(q.dtype)


def setup_inputs(seed: int = 0) -> dict:
    key = jax.random.key(seed)
    ks = jax.random.split(key, 14)
    f = jnp.float32
    nrm = jax.random.normal
    return {
        "x": nrm(ks[0], (BATCH, SEQ, D_MODEL), f),
        "norm_attn": 1.0 + 0.01 * nrm(ks[1], (DEPTH, D_MODEL), f),
        "w_in": nrm(ks[2], (DEPTH, D_MODEL, N_IN), f) * D_MODEL ** -0.5,
        "qk_gain": 1.0 + 0.01 * nrm(ks[3], (DEPTH, N_QK_NORMS, HEAD_DIM), f),
        "cmp_pe": 0.02 * nrm(ks[4], (DEPTH, 2, CMP_BLOCK, HEAD_DIM), f),
        "cmp_w1": nrm(ks[5], (DEPTH, 2, CMP_BLOCK * HEAD_DIM, HEAD_DIM), f) * (CMP_BLOCK * HEAD_DIM) ** -0.5,
        "cmp_w2": nrm(ks[6], (DEPTH, 2, HEAD_DIM, HEAD_DIM), f) * HEAD_DIM ** -0.5,
        "sinks": 0.5 * nrm(ks[7], (DEPTH, B_Q_HEADS), f),
        "rel_bias": 0.5 * nrm(ks[8], (REL_BUCKETS, N_HEADS), f),
        "w_out": nrm(ks[9], (DEPTH, D_MODEL, D_MODEL), f) * D_MODEL ** -0.5,
        "norm_ffn": 1.0 + 0.01 * nrm(ks[10], (DEPTH, D_MODEL), f),
        "w_gate": nrm(ks[11], (DEPTH, D_MODEL, D_FF), f) * D_MODEL ** -0.5,
        "w_up": nrm(ks[12], (DEPTH, D_MODEL, D_FF), f) * D_MODEL ** -0.5,
        "w_down": nrm(ks[13], (DEPTH, D_FF, D_MODEL), f) * D_FF ** -0.5,
    }


def reference(x, norm_attn, w_in, qk_gain, cmp_pe, cmp_w1, cmp_w2, sinks, rel_bias, w_out, norm_ffn, w_gate, w_up, w_down):
    B, T, _ = x.shape
    offsets = np.cumsum(SPLIT_SIZES)[:-1].tolist()
    bias_a = rel_bias[:, :A_Q_HEADS]
    bias_b = rel_bias[:, A_Q_HEADS:A_Q_HEADS + B_Q_HEADS]
    bias_c = rel_bias[:, A_Q_HEADS + B_Q_HEADS:]

    def heads(t, n):
        return t.reshape(B, T, n, HEAD_DIM)

    for l in range(DEPTH):
        g = qk_gain[l]
        h = rms_norm(x, norm_attn[l])
        proj = jnp.einsum('btd,dn->btn', h, w_in[l])
        (qa, kca, vca, ksa, vsa, kwa, vwa, ga, qb, kb, vb, qc, kc, vc) = jnp.split(proj, offsets, axis=-1)
        o_a = nsa_mixer(rms_norm(heads(qa, A_Q_HEADS), g[0]),
                        heads(kca, A_KV_HEADS), heads(vca, A_KV_HEADS),
                        rms_norm(heads(ksa, A_KV_HEADS), g[2]), heads(vsa, A_KV_HEADS),
                        rms_norm(heads(kwa, A_KV_HEADS), g[3]), heads(vwa, A_KV_HEADS),
                        ga.reshape(B, T, A_Q_HEADS, 3), g[1], cmp_pe[l], cmp_w1[l], cmp_w2[l], bias_a)
        o_b, _ = banded_attention(rms_norm(heads(qb, B_Q_HEADS), g[4]), rms_norm(heads(kb, B_KV_HEADS), g[5]),
                                  heads(vb, B_KV_HEADS), bias_b, SWA_WINDOW - 1, sinks=sinks[l])
        o_c = dilated_mixer(rms_norm(heads(qc, C_Q_HEADS), g[6]), rms_norm(heads(kc, C_KV_HEADS), g[7]),
                            heads(vc, C_KV_HEADS), bias_c)
        mix = jnp.concatenate([o_a.reshape(B, T, -1), o_b.reshape(B, T, -1), o_c.reshape(B, T, -1)], axis=-1)
        x = x + jnp.einsum('btm,md->btd', mix.astype(x.dtype), w_out[l])
        h = rms_norm(x, norm_ffn[l])
        x = x + jnp.einsum('btf,fd->btd', jax.nn.silu(h @ w_gate[l]) * (h @ w_up[l]), w_down[l])
    return x
```

```cpp
#include <hip/hip_runtime.h>
#include <hip/hip_cooperative_groups.h>
#include <cstdio>
#include <cstdint>
namespace cg = cooperative_groups;

#ifndef PR_GEMM
#define PR_GEMM 1
#endif
#ifndef PR_ATT1
#define PR_ATT1 1
#endif
#ifndef PR_ATT2
#define PR_ATT2 1
#endif
#ifndef PR_MISC
#define PR_MISC 1
#endif
#ifndef MK_ONE_LAUNCH
#define MK_ONE_LAUNCH 1
#endif

namespace pg8 {
#define PG8_LAS __attribute__((address_space(3)))
typedef unsigned short bf16_t;
typedef short bf16x8 __attribute__((ext_vector_type(8)));
typedef float f32x4 __attribute__((ext_vector_type(4)));
typedef unsigned u32x4 __attribute__((ext_vector_type(4)));
constexpr int BM = 256, BK = 64, HALF = 128, HTB = HALF * BK * 2  , STAGE_BYTES = 8 * HTB, NXCD = 8, WGM = 8;

__host__ __device__ __forceinline__ int lds_byte(int r, int c) { const int st = (r >> 4) * 2 + (c >> 5), rr = r & 15, cc = c & 31, ob = rr * 64 + cc * 2; return st * 1024 + (ob ^ (((ob >> 9) & 1) << 5)); }
__host__ __device__ __forceinline__ void stage_rc(int b, int& R, int& C) { const int st = b / 1024, sb = b % 1024, swz = sb ^ (((sb >> 9) & 1) << 5); R = (st >> 1) * 16 + swz / 64; C = (st & 1) * 32 + (swz % 64) / 2; }
__host__ __device__ __forceinline__ int perm32(int rho) { const int n = rho >> 4, i = rho & 15; return 8 * (i >> 2) + 4 * n + (i & 3); }

struct Unit { int pm, pn; };
struct Gemm { const bf16_t* A; const bf16_t* Bt; int M, N, K; };

struct StaticOrder {
    int nM, nN, nwg, G, c;
    __host__ __device__ void init(int M, int N, int G_, int c_) { nM = M / BM; nN = N / BM; nwg = nM * nN; G = G_; c = c_; }
    __host__ __device__ bool next(int i, Unit& u) const {
        const long L = (long)i * G + c; if (L >= nwg) return false;
        int wgid = (int)L; { const int q = nwg / NXCD, r = nwg % NXCD, xcd = wgid % NXCD, off = wgid / NXCD; wgid = (xcd < r ? xcd * (q + 1) : r * (q + 1) + (xcd - r) * q) + off; }
        const int nig = WGM * nN, gid = wgid / nig, fm = gid * WGM, gsz = (nM - fm) < WGM ? (nM - fm) : WGM;
        u.pm = fm + ((wgid % nig) % gsz); u.pn = (wgid % nig) / gsz; return true;
    }
    __device__ __forceinline__ void a_ready(const Unit&) const {}
    __device__ __forceinline__ void done(const Unit&) const {}
};

__device__ __forceinline__ unsigned cvt_pk_bf16(float lo, float hi) { unsigned r; asm volatile("v_cvt_pk_bf16_f32 %0, %1, %2" : "=v"(r) : "v"(lo), "v"(hi)); return r; }
template <class Epi, class Sched, bool ALIGN_EPI = false, bool SP2 = false>
__device__ __forceinline__ void gemm_phase(PG8_LAS unsigned char* lds, const Gemm g, const Sched& S, const Epi& E) {
    int tid_ = threadIdx.x; asm volatile("" : "+v"(tid_));
    const int tid = tid_, wid = __builtin_amdgcn_readfirstlane(tid >> 6), lane = tid & 63, wr = wid >> 2, wc = wid & 3, fr = lane & 15, fq = lane >> 4;
    const int K = g.K, nt = K / BK;
    unsigned voffA[2], voffB[2];
#pragma unroll
    for (int i = 0; i < 2; ++i) { int R, C; stage_rc(tid * 16 + i * 8192, R, C); const int Rb = Epi::PERM ? ((R & ~31) + perm32(R & 31)) : R;
        voffA[i] = (unsigned)(R * K + C) * 2u; voffB[i] = (unsigned)(Rb * K + C) * 2u; }
    const size_t kstep = (size_t)(BK * 2);
    const size_t hstep = (size_t)HALF * K * 2;
    const size_t tstep = 2 * hstep;
    const unsigned ldsw = (unsigned)wid * 1024u;
    const int aoff = lds_byte(wr * 64 + fr, fq * 8), boff = lds_byte(wc * 32 + fr, fq * 8);
#define PG8_SA(b, h) (((b) * 2 + (h)) * HTB)
#define PG8_SB(b, h) ((4 + (b) * 2 + (h)) * HTB)
#define PG8_STAGE(bufoff, gbase, voff) do { _Pragma("unroll") for (int _i = 0; _i < 2; ++_i) \
        __builtin_amdgcn_global_load_lds((const unsigned*)((const char*)(gbase) + (voff)[_i]), (PG8_LAS unsigned*)(lds + (bufoff) + ldsw + _i * 8192), 16, 0, 0); } while (0)
#define PG8_LDA(dst, b, h) do { _Pragma("unroll") for (int m = 0; m < 4; ++m) _Pragma("unroll") for (int k = 0; k < 2; ++k) dst[m][k] = *(const PG8_LAS bf16x8*)(lds + PG8_SA(b, h) + aoff + m * 2048 + k * 1024); } while (0)
#define PG8_LDB(dst, b, h) do { _Pragma("unroll") for (int n = 0; n < 2; ++n) _Pragma("unroll") for (int k = 0; k < 2; ++k) dst[n][k] = *(const PG8_LAS bf16x8*)(lds + PG8_SB(b, h) + boff + n * 2048 + k * 1024); } while (0)
#define PG8_MMA(ai, bj, At, Bt) do { __builtin_amdgcn_s_setprio(1); _Pragma("unroll") for (int m = 0; m < 4; ++m) _Pragma("unroll") for (int n = 0; n < 2; ++n) _Pragma("unroll") for (int k = 0; k < 2; ++k) \
        acc[ai][bj][m][n] = __builtin_amdgcn_mfma_f32_16x16x32_bf16(Bt[n][k], At[m][k], acc[ai][bj][m][n], 0, 0, 0); __builtin_amdgcn_s_setprio(0); } while (0)
#define PG8_WAIT_V(n) asm volatile("s_waitcnt vmcnt(" #n ")" ::: "memory")
#define PG8_WAIT_L(n) asm volatile("s_waitcnt lgkmcnt(" #n ")" ::: "memory")
#define PG8_BAR __builtin_amdgcn_s_barrier()
#define PG8_SCHED __builtin_amdgcn_sched_barrier(0)
    Unit cur, nxt; int ui = 0;
    if (!S.next(0, cur)) return;
    f32x4 acc[2][2][4][2];
#pragma unroll
    for (int a = 0; a < 2; ++a)
#pragma unroll
        for (int b = 0; b < 2; ++b)
#pragma unroll
            for (int m = 0; m < 4; ++m)
#pragma unroll
                for (int n = 0; n < 2; ++n) acc[a][b][m][n] = (f32x4){0.f, 0.f, 0.f, 0.f};
    bf16x8 At[4][2], B0[2][2], B1[2][2];
    const char* cA = (const char*)g.A + (size_t)cur.pm * tstep; const char* cB = (const char*)g.Bt + (size_t)cur.pn * tstep;
    S.a_ready(cur);
    if constexpr (SP2) {
        PG8_STAGE(PG8_SB(0, 0), cB, voffB); PG8_STAGE(PG8_SB(0, 1), cB + hstep, voffB); PG8_STAGE(PG8_SA(0, 0), cA, voffA); PG8_STAGE(PG8_SA(0, 1), cA + hstep, voffA);
        if (wr == 1) PG8_BAR;
        PG8_WAIT_V(2); PG8_BAR;
        PG8_STAGE(PG8_SB(1, 0), cB + kstep, voffB); PG8_STAGE(PG8_SA(1, 0), cA + kstep, voffA); PG8_STAGE(PG8_SB(1, 1), cB + hstep + kstep, voffB);
        PG8_WAIT_V(6); PG8_BAR;
    } else {
        PG8_STAGE(PG8_SB(0, 0), cB, voffB); PG8_STAGE(PG8_SA(0, 0), cA, voffA); PG8_STAGE(PG8_SB(0, 1), cB + hstep, voffB); PG8_STAGE(PG8_SA(0, 1), cA + hstep, voffA);
        if (wr == 1) PG8_BAR;
        PG8_WAIT_V(4); PG8_BAR;
        PG8_STAGE(PG8_SB(1, 0), cB + kstep, voffB); PG8_STAGE(PG8_SA(1, 0), cA + kstep, voffA); PG8_STAGE(PG8_SB(1, 1), cB + hstep + kstep, voffB);
        PG8_WAIT_V(6); PG8_BAR;
    }
    for (;;) {
        const bool has_next = S.next(ui + 1, nxt);
        const char* nA = has_next ? (const char*)g.A + (size_t)nxt.pm * tstep : cA; const char* nB = has_next ? (const char*)g.Bt + (size_t)nxt.pn * tstep : cB;
        for (int t = 0; t < nt; t += 2) {
            const bool last = (t == nt - 2);
            const char* a1 = cA + (size_t)(t + 1) * kstep;
            const char* a2 = last ? nA : cA + (size_t)(t + 2) * kstep; const char* b2 = last ? nB : cB + (size_t)(t + 2) * kstep;
            const char* a3 = a2 + kstep; const char* b3 = b2 + kstep;
            if (last && has_next) S.a_ready(nxt);
            if constexpr (SP2) {
            PG8_LDB(B0, 0, 0); PG8_LDB(B1, 0, 1); PG8_SCHED; PG8_LDA(At, 0, 0); PG8_STAGE(PG8_SA(1, 1), a1 + hstep, voffA);
            PG8_WAIT_V(8); PG8_WAIT_L(0); PG8_BAR; PG8_MMA(0, 0, At, B0); PG8_MMA(0, 1, At, B1); PG8_BAR; PG8_SCHED;
            PG8_LDA(At, 0, 1); PG8_STAGE(PG8_SB(0, 0), b2, voffB); PG8_STAGE(PG8_SB(0, 1), b2 + hstep, voffB); PG8_STAGE(PG8_SA(0, 0), a2, voffA);
            PG8_WAIT_V(8); PG8_WAIT_L(0); PG8_BAR; PG8_MMA(1, 0, At, B0); PG8_MMA(1, 1, At, B1); PG8_BAR; PG8_SCHED;
            PG8_LDB(B0, 1, 0); PG8_LDB(B1, 1, 1); PG8_SCHED; PG8_LDA(At, 1, 0); PG8_STAGE(PG8_SA(0, 1), a2 + hstep, voffA);
            PG8_WAIT_V(8); PG8_WAIT_L(0); PG8_BAR; PG8_MMA(0, 0, At, B0); PG8_MMA(0, 1, At, B1); PG8_BAR; PG8_SCHED;
            PG8_LDA(At, 1, 1); PG8_STAGE(PG8_SB(1, 0), b3, voffB); PG8_STAGE(PG8_SB(1, 1), b3 + hstep, voffB); PG8_STAGE(PG8_SA(1, 0), a3, voffA);
            PG8_WAIT_V(8); PG8_WAIT_L(0); PG8_BAR; PG8_MMA(1, 0, At, B0); PG8_MMA(1, 1, At, B1); PG8_BAR; PG8_SCHED;
            } else {
            PG8_LDB(B0, 0, 0); PG8_SCHED; PG8_LDA(At, 0, 0); PG8_STAGE(PG8_SA(1, 1), a1 + hstep, voffA);
            PG8_WAIT_L(8); PG8_BAR; PG8_WAIT_L(0); PG8_MMA(0, 0, At, B0); PG8_BAR; PG8_SCHED;
            PG8_LDB(B1, 0, 1); PG8_STAGE(PG8_SB(0, 0), b2, voffB);
            PG8_BAR; PG8_WAIT_L(0); PG8_MMA(0, 1, At, B1); PG8_BAR;
            PG8_LDA(At, 0, 1); PG8_STAGE(PG8_SA(0, 0), a2, voffA);
            PG8_BAR; PG8_WAIT_L(0); PG8_MMA(1, 0, At, B0); PG8_BAR; PG8_SCHED;
            PG8_STAGE(PG8_SB(0, 1), b2 + hstep, voffB);
            PG8_WAIT_V(6); PG8_BAR; PG8_MMA(1, 1, At, B1); PG8_BAR;
            PG8_LDB(B0, 1, 0); PG8_SCHED; PG8_LDA(At, 1, 0); PG8_STAGE(PG8_SA(0, 1), a2 + hstep, voffA);
            PG8_WAIT_L(8); PG8_BAR; PG8_WAIT_L(0); PG8_MMA(0, 0, At, B0); PG8_BAR; PG8_SCHED;
            PG8_LDB(B1, 1, 1); PG8_STAGE(PG8_SB(1, 0), b3, voffB);
            PG8_BAR; PG8_WAIT_L(0); PG8_MMA(0, 1, At, B1); PG8_BAR;
            PG8_LDA(At, 1, 1); PG8_STAGE(PG8_SA(1, 0), a3, voffA);
            PG8_BAR; PG8_WAIT_L(0); PG8_MMA(1, 0, At, B0); PG8_BAR; PG8_SCHED;
            PG8_STAGE(PG8_SB(1, 1), b3 + hstep, voffB);
            PG8_WAIT_V(6); PG8_BAR; PG8_MMA(1, 1, At, B1); PG8_BAR;
            }
        }
        if constexpr (ALIGN_EPI) { if (wr == 0) PG8_BAR; }
        if constexpr (!Epi::AFTER_DRAIN) { E(acc, cur, wr, wc, fr, fq); S.done(cur); }
        if (!has_next) break;
#pragma unroll
        for (int a = 0; a < 2; ++a)
#pragma unroll
            for (int b = 0; b < 2; ++b)
#pragma unroll
                for (int m = 0; m < 4; ++m)
#pragma unroll
                    for (int n = 0; n < 2; ++n) acc[a][b][m][n] = (f32x4){0.f, 0.f, 0.f, 0.f};
        cur = nxt; cA = nA; cB = nB; ++ui;
        if constexpr (ALIGN_EPI) { if (wr == 1) PG8_BAR; }
    }
    PG8_WAIT_V(0);
    if constexpr (!ALIGN_EPI) { if (wr == 0) PG8_BAR; }
    PG8_BAR;
    if constexpr (Epi::AFTER_DRAIN) { E.fused(acc, cur, wr, wc, fr, fq, lds, wid, lane); S.done(cur); }
#undef PG8_SA
#undef PG8_SB
#undef PG8_STAGE
#undef PG8_LDA
#undef PG8_LDB
#undef PG8_MMA
#undef PG8_WAIT_V
#undef PG8_WAIT_L
#undef PG8_BAR
#undef PG8_SCHED
}
}

#define LAS __attribute__((address_space(3)))
typedef unsigned short bf16;
typedef unsigned v4u __attribute__((ext_vector_type(4)));
typedef unsigned v2u __attribute__((ext_vector_type(2)));
typedef float f32x4 __attribute__((ext_vector_type(4)));
typedef short bf16x8 __attribute__((ext_vector_type(8)));
typedef short s16x4 __attribute__((ext_vector_type(4)));
typedef float f32x2_t __attribute__((ext_vector_type(2)));
typedef __bf16 bf16x2_t __attribute__((ext_vector_type(2)));
typedef unsigned long long u64;

constexpr int NB = 4, T = 4096, DM = 2048, M = NB * T, NP = 5120, FF = 5632, NIN = 4882, NWAVES = 8;
constexpr float SCALE = 0.08838834764831845f, EPS = 1e-6f;
constexpr int C_QA = 0, C_KCA = 768, C_VCA = 1024, C_KSA = 1280, C_VSA = 1536, C_KWA = 1792, C_VWA = 2048,
              C_QB = 2304, C_KB = 2816, C_VB = 3072, C_QC = 3328, C_KC = 4096, C_VC = 4480, C_GA = 4864;
constexpr size_t MiB = 1u << 20;
constexpr size_t WS_BL = 0, WS_M0 = 512 * 1024, WS_KC = 1 * MiB, WS_VCT = 1 * MiB + 512 * 1024, WS_SEL = 2 * MiB, WS_LSE = 2 * MiB + 512 * 1024;
constexpr size_t WS_CTL = 3 * MiB, CTL_BYTES = 16384;
constexpr size_t WS_W = 4 * MiB, W_LAYER = 97 * MiB, W_IN = 0, W_OUT = 20 * MiB, W_GU = 28 * MiB, W_D = 72 * MiB, W_C1 = 94 * MiB, W_C2 = 96 * MiB;
constexpr size_t WS_H = 198 * MiB, WS_MIX = 262 * MiB, WS_P = 326 * MiB, WS_END = 502 * MiB;
constexpr int LDS_BYTES = 155648;

__device__ __forceinline__ unsigned f2bf(float f) { unsigned u = __builtin_bit_cast(unsigned, f); return (u + 0x7fffu + ((u >> 16) & 1u)) >> 16; }
__device__ __forceinline__ unsigned pk2(float lo, float hi) { f32x2_t v = {lo, hi}; bf16x2_t b = __builtin_convertvector(v, bf16x2_t); return __builtin_bit_cast(unsigned, b); }
__device__ __forceinline__ float bf2f(unsigned short h) { return __builtin_bit_cast(float, (unsigned)h << 16); }
__device__ __forceinline__ float bflo(unsigned u) { return __builtin_bit_cast(float, u << 16); }
__device__ __forceinline__ float bfhi(unsigned u) { return __builtin_bit_cast(float, u & 0xffff0000u); }
__device__ __forceinline__ float wave_sum(float v) {
#pragma unroll
    for (int o = 1; o < 64; o <<= 1) v += __shfl_xor(v, o);
    return v;
}
__device__ __forceinline__ float sigmoidf_(float x) { return 1.f / (1.f + __expf(-x)); }
__device__ __forceinline__ s16x4 vtr(LAS const unsigned char* p) { typedef short v4i16_t __attribute__((ext_vector_type(4))); return __builtin_bit_cast(s16x4, __builtin_amdgcn_ds_read_tr16_b64_v4i16((LAS v4i16_t*)p)); }

struct Args {
    const float *x, *norm_attn, *w_in, *qk_gain, *cmp_pe, *cmp_w1, *cmp_w2, *sinks, *rel_bias, *w_out, *norm_ffn, *w_gate, *w_up, *w_down;
    float* out; unsigned char* ws; int ph_lo, ph_hi;
};

__device__ __forceinline__ int unit_gain(int u) {
    if (u < 6) return 0; if (u >= 10 && u < 12) return 2; if (u >= 14 && u < 16) return 3; if (u >= 18 && u < 22) return 4;
    if (u >= 22 && u < 24) return 5; if (u >= 26 && u < 32) return 6; if (u >= 32 && u < 35) return 7; return -1;
}
struct EpiStoreBf16 {
    static constexpr bool PERM = true, AFTER_DRAIN = false;
    bf16* O; int ldc; const float* gains; LAS float* ssx;
    __device__ __forceinline__ void operator()(const f32x4 (&acc)[2][2][4][2], const pg8::Unit& u, int wr, int wc, int fr, int fq) const {
        const int row0 = u.pm * 256 + wr * 64 + fr, col0 = u.pn * 256 + wc * 32 + 8 * fq;
        const int g0 = unit_gain(u.pn * 2), g1 = unit_gain(u.pn * 2 + 1);
        float rn[2][4][2];
        if (g0 >= 0 || g1 >= 0) {
#pragma unroll
            for (int ai = 0; ai < 2; ++ai)
#pragma unroll
                for (int m = 0; m < 4; ++m)
#pragma unroll
                    for (int bj = 0; bj < 2; ++bj) { const f32x4 v0 = acc[ai][bj][m][0], v1 = acc[ai][bj][m][1];
                        float ss = (v0[0] * v0[0] + v0[1] * v0[1]) + (v0[2] * v0[2] + v0[3] * v0[3]) + (v1[0] * v1[0] + v1[1] * v1[1]) + (v1[2] * v1[2] + v1[3] * v1[3]);
                        ss += __shfl_xor(ss, 16); ss += __shfl_xor(ss, 32);
                        if (fq == 0) ssx[(((((wr * 2 + ai) * 4 + m) * 2 + bj) * 16 + fr) << 2) + wc] = ss; }
            asm volatile("s_waitcnt lgkmcnt(0)" ::: "memory");
            __builtin_amdgcn_s_barrier();
            __builtin_amdgcn_sched_barrier(0);
#pragma unroll
            for (int ai = 0; ai < 2; ++ai)
#pragma unroll
                for (int m = 0; m < 4; ++m)
#pragma unroll
                    for (int bj = 0; bj < 2; ++bj) { const f32x4 p = *(const LAS f32x4*)(ssx + (((((wr * 2 + ai) * 4 + m) * 2 + bj) * 16 + fr) << 2));
                        const float tot = (p[0] + p[1]) + (p[2] + p[3]);
                        rn[ai][m][bj] = ((bj ? g1 : g0) >= 0) ? 1.f / sqrtf(tot * (1.f / 128.f) + EPS) : 1.f; }
        }
        f32x4 gv[2][2];
#pragma unroll
        for (int bj = 0; bj < 2; ++bj) { const int gi = bj ? g1 : g0;
            if (gi >= 0) { const float* gp = gains + gi * 128 + wc * 32 + 8 * fq; gv[bj][0] = *(const f32x4*)gp; gv[bj][1] = *(const f32x4*)(gp + 4); }
            else { gv[bj][0] = (f32x4){1.f, 1.f, 1.f, 1.f}; gv[bj][1] = gv[bj][0]; } }
#pragma unroll
        for (int ai = 0; ai < 2; ++ai)
#pragma unroll
            for (int m = 0; m < 4; ++m) { bf16* rowp = O + (size_t)(row0 + ai * 128 + m * 16) * ldc + col0;
#pragma unroll
                for (int bj = 0; bj < 2; ++bj) { const float r = (g0 >= 0 || g1 >= 0) ? rn[ai][m][bj] : 1.f;
                    const f32x4 v0 = acc[ai][bj][m][0] * r * gv[bj][0], v1 = acc[ai][bj][m][1] * r * gv[bj][1];
                    v4u w; w.x = pk2(v0[0], v0[1]); w.y = pk2(v0[2], v0[3]); w.z = pk2(v1[0], v1[1]); w.w = pk2(v1[2], v1[3]);
                    *(v4u*)(rowp + bj * 128) = w; } }
    }
};
struct EpiResidF32 {
    static constexpr bool PERM = true, AFTER_DRAIN = false;
    const float* R; float* O; int ldc;
    __device__ __forceinline__ void operator()(const f32x4 (&acc)[2][2][4][2], const pg8::Unit& u, int wr, int wc, int fr, int fq) const {
        const int row0 = u.pm * 256 + wr * 64 + fr, col0 = u.pn * 256 + wc * 32 + 8 * fq;
#pragma unroll
        for (int ai = 0; ai < 2; ++ai)
#pragma unroll
            for (int m = 0; m < 4; ++m) { const size_t off = (size_t)(row0 + ai * 128 + m * 16) * ldc + col0;
#pragma unroll
                for (int bj = 0; bj < 2; ++bj) {
                    const f32x4 r0 = *(const f32x4*)(R + off + bj * 128), r1 = *(const f32x4*)(R + off + bj * 128 + 4);
                    *(f32x4*)(O + off + bj * 128) = r0 + acc[ai][bj][m][0]; *(f32x4*)(O + off + bj * 128 + 4) = r1 + acc[ai][bj][m][1]; } }
    }
};
struct EpiSwiGLU {
    static constexpr bool PERM = true, AFTER_DRAIN = false;
    bf16* O; int ldc;
    __device__ __forceinline__ void operator()(const f32x4 (&acc)[2][2][4][2], const pg8::Unit& u, int wr, int wc, int fr, int fq) const {
        const int row0 = u.pm * 256 + wr * 64 + fr, col0 = u.pn * 128 + wc * 32 + 8 * fq;
#pragma unroll
        for (int ai = 0; ai < 2; ++ai)
#pragma unroll
            for (int m = 0; m < 4; ++m) { bf16* rowp = O + (size_t)(row0 + ai * 128 + m * 16) * ldc + col0;
                float r[8];
#pragma unroll
                for (int n = 0; n < 2; ++n)
#pragma unroll
                    for (int i = 0; i < 4; ++i) { const float g = acc[ai][0][m][n][i], up = acc[ai][1][m][n][i]; r[n * 4 + i] = g * sigmoidf_(g) * up; }
                v4u w; w.x = pk2(r[0], r[1]); w.y = pk2(r[2], r[3]); w.z = pk2(r[4], r[5]); w.w = pk2(r[6], r[7]);
                *(v4u*)rowp = w; }
    }
};

struct Frame {
    LAS unsigned char* lds;
    int tid, lane, wave, G, bid;
    const Args* a;
    unsigned char* ws;
};
#define WSP(T_, off) ((T_*)(F.ws + (off)))

__device__ __forceinline__ int rel_bucket(int d) {
    if (d < 16) return d;
    int b = 16;
    b += (d >= 22); b += (d >= 30); b += (d >= 40); b += (d >= 54); b += (d >= 73); b += (d >= 99); b += (d >= 134); b += (d >= 182);
    b += (d >= 246); b += (d >= 332); b += (d >= 450); b += (d >= 609); b += (d >= 825); b += (d >= 1117); b += (d >= 1513);
    return b;
}

template <int BLK32 = 0>
__device__ __forceinline__ void tr_item(const float* W, int Nsrc, int K, int k0, int sc, bf16* WTrow0, LAS float* scr, int lane) {
    float v[32];
    const float* wp = W + (size_t)(k0 + (lane >> 5)) * Nsrc + (sc >= 0 ? sc : 0);
#pragma unroll
    for (int i = 0; i < 32; ++i) v[i] = wp[(size_t)(2 * i) * Nsrc];
#pragma unroll
    for (int i = 0; i < 32; ++i) { const int kk = 2 * i + (lane >> 5); scr[kk * 33 + (lane & 31)] = sc >= 0 ? v[i] : 0.f; }
    asm volatile("s_waitcnt lgkmcnt(0)" ::: "memory");
    const int c = lane & 7;
#pragma unroll
    for (int j = 0; j < 4; ++j) { const int n = (lane >> 3) + 8 * j; const LAS float* s = scr + (8 * c) * 33 + n;
        v4u o; o.x = pk2(s[0 * 33], s[1 * 33]); o.y = pk2(s[2 * 33], s[3 * 33]); o.z = pk2(s[4 * 33], s[5 * 33]); o.w = pk2(s[6 * 33], s[7 * 33]);
        if (BLK32) *(v4u*)(WTrow0 + ((size_t)((k0 + 8 * c) >> 5) * 128 + n) * 32 + ((k0 + 8 * c) & 31)) = o;
        else *(v4u*)(WTrow0 + (size_t)n * K + k0 + 8 * c) = o; }
    asm volatile("s_waitcnt lgkmcnt(0)" ::: "memory");
}
__device__ __forceinline__ void prologue_phase(Frame& F) {
    const Args& A = *F.a;
    LAS float* scr = (LAS float*)(F.lds + F.wave * 16384);
    const int gw = F.bid * NWAVES + F.wave, NGW = F.G * NWAVES, lane = F.lane;
    constexpr int I_IN = 32 * 160, I_OUT = 32 * 64, I_GU = 32 * 352, I_D = 88 * 64, I_C1 = 2 * 64 * 4, I_C2 = 2 * 2 * 4;
    constexpr int I_LAYER = I_IN + I_OUT + I_GU + I_D + I_C1 + I_C2;
    for (int it = gw; it < 2 * I_LAYER; it += NGW) {
        const int l = it / I_LAYER; int r = it - l * I_LAYER;
        unsigned char* wl = F.ws + WS_W + (size_t)l * W_LAYER;
        if (r < I_IN) { const int kb = r / 160, nb = r % 160, n = nb * 32 + (lane & 31);
            const int sc = n < 2304 ? n : (n < 4864 ? n + 18 : (n < 4882 ? n - 4864 + 2304 : -1));
            tr_item(A.w_in + (size_t)l * DM * NIN, NIN, DM, kb * 64, sc, (bf16*)(wl + W_IN) + (size_t)nb * 32 * DM, scr, lane); continue; }
        r -= I_IN;
        if (r < I_OUT) { const int kb = r / 64, nb = r % 64;
            tr_item(A.w_out + (size_t)l * DM * DM, DM, DM, kb * 64, nb * 32 + (lane & 31), (bf16*)(wl + W_OUT) + (size_t)nb * 32 * DM, scr, lane); continue; }
        r -= I_OUT;
        if (r < I_GU) { const int kb = r / 352, nb = r % 352, r0 = nb * 32, blk = r0 >> 8, half = (r0 >> 7) & 1, w0 = r0 & 127;
            const float* src = (half ? A.w_up : A.w_gate) + (size_t)l * DM * FF;
            tr_item(src, FF, DM, kb * 64, blk * 128 + w0 + (lane & 31), (bf16*)(wl + W_GU) + (size_t)r0 * DM, scr, lane); continue; }
        r -= I_GU;
        if (r < I_D) { const int kb = r / 64, nb = r % 64;
            tr_item(A.w_down + (size_t)l * FF * DM, DM, FF, kb * 64, nb * 32 + (lane & 31), (bf16*)(wl + W_D) + (size_t)nb * 32 * FF, scr, lane); continue; }
        r -= I_D;
        if (r < I_C1) { const int kv = r / 256, r2 = r % 256, kb = r2 / 4, nb = r2 % 4;
            tr_item<1>(A.cmp_w1 + (size_t)(l * 2 + kv) * 4096 * 128, 128, 4096, kb * 64, nb * 32 + (lane & 31), (bf16*)(wl + W_C1) + (size_t)kv * 128 * 4096 + (size_t)nb * 32 * 32, scr, lane); continue; }
        r -= I_C1;
        { const int kv = r / 8, r2 = r % 8, kb = r2 / 4, nb = r2 % 4;
            tr_item(A.cmp_w2 + (size_t)(l * 2 + kv) * 128 * 128, 128, 128, kb * 64, nb * 32 + (lane & 31), (bf16*)(wl + W_C2) + (size_t)(kv * 128 + nb * 32) * 128, scr, lane); }
    }
    float* BL = WSP(float, WS_BL);
    for (int i = F.bid * 512 + F.tid; i < 16 * 4096; i += F.G * 512) { const int h = i >> 12, d = i & 4095; BL[i] = A.rel_bias[rel_bucket(d) * 16 + h]; }
    if (F.bid == 0 && F.wave == 0) {
        float bm = 0.f;
#pragma unroll
        for (int i = 0; i < 8; ++i) bm = fmaxf(bm, fabsf(A.rel_bias[lane + 64 * i]));
#pragma unroll
        for (int o = 1; o < 64; o <<= 1) bm = fmaxf(bm, __shfl_xor(bm, o));
        for (int l = 0; l < 2; ++l) {
            float g[8];
#pragma unroll
            for (int i = 0; i < 8; ++i) { const float* gp = A.qk_gain + (size_t)(l * 8 + i) * 128; float v = fmaxf(fabsf(gp[lane]), fabsf(gp[lane + 64]));
#pragma unroll
                for (int o = 1; o < 64; o <<= 1) v = fmaxf(v, __shfl_xor(v, o));
                g[i] = v; }
            if (lane == 0) { float* M0 = WSP(float, WS_M0) + l * 8;
                const float c = 128.f * SCALE * 1.4426950408889634f, bb = bm * 1.4426950408889634f + 1.f;
                M0[0] = fminf(c * g[0] * g[2] + bb, 100.f); M0[1] = fminf(c * g[0] * g[3] + bb, 100.f); M0[2] = fminf(c * g[4] * g[5] + bb, 100.f);
                M0[3] = fminf(c * g[6] * g[7] + bb, 100.f); M0[4] = fminf(c * g[0] * g[1] + bb, 100.f); }
        }
    }
}

__device__ __forceinline__ void rms_phase(Frame& F, const float* x, const float* g, bf16* out) {
    const int gw = F.bid * NWAVES + F.wave, NGW = F.G * NWAVES, lane = F.lane;
    f32x4 gv[8];
#pragma unroll
    for (int j = 0; j < 8; ++j) gv[j] = ((const f32x4*)g)[lane + 64 * j];
    for (int m = gw; m < M; m += NGW) {
        const f32x4* xr = (const f32x4*)(x + (size_t)m * DM) + lane;
        f32x4 v[8]; float ss = 0.f;
#pragma unroll
        for (int j = 0; j < 8; ++j) { v[j] = xr[64 * j]; ss += (v[j].x * v[j].x + v[j].y * v[j].y) + (v[j].z * v[j].z + v[j].w * v[j].w); }
        const float r = 1.f / sqrtf(wave_sum(ss) * (1.f / DM) + EPS);
        v2u* o8 = (v2u*)(out + (size_t)m * DM) + lane;
#pragma unroll
        for (int j = 0; j < 8; ++j) { v2u w; w.x = pk2(v[j].x * r * gv[j].x, v[j].y * r * gv[j].y); w.y = pk2(v[j].z * r * gv[j].z, v[j].w * r * gv[j].w); o8[64 * j] = w; }
    }
}

__device__ __forceinline__ void qknorm_phase(Frame& F, int layer) {
    const Args& A = *F.a; bf16* P = WSP(bf16, WS_P);
    const int gw = F.bid * NWAVES + F.wave, NGW = F.G * NWAVES, lane = F.lane, sub = lane & 15, quad = lane >> 4;
    const int total = M * 25 / 4;
    constexpr int U = 5;
    for (int base = gw; base < total; base += NGW * U) {
        v4u w[U]; bf16* pp[U]; int gsel[U]; bool ok[U];
#pragma unroll
        for (int u = 0; u < U; ++u) {
            const int wi = base + u * NGW; ok[u] = wi < total;
            const int gi = (ok[u] ? wi : gw) * 4 + quad, m = gi / 25, uu = gi - m * 25;
            int unit, gidx;
            if (uu < 6) { unit = uu; gidx = 0; } else if (uu < 8) { unit = 10 + (uu - 6); gidx = 2; } else if (uu < 10) { unit = 14 + (uu - 8); gidx = 3; }
            else if (uu < 14) { unit = 18 + (uu - 10); gidx = 4; } else if (uu < 16) { unit = 22 + (uu - 14); gidx = 5; } else if (uu < 22) { unit = 26 + (uu - 16); gidx = 6; }
            else { unit = 32 + (uu - 22); gidx = 7; }
            pp[u] = P + (size_t)m * NP + unit * 128 + sub * 8; gsel[u] = gidx;
            w[u] = *(const v4u*)pp[u];
        }
#pragma unroll
        for (int u = 0; u < U; ++u) {
            float v[8] = {bflo(w[u].x), bfhi(w[u].x), bflo(w[u].y), bfhi(w[u].y), bflo(w[u].z), bfhi(w[u].z), bflo(w[u].w), bfhi(w[u].w)};
            float ss = 0.f;
#pragma unroll
            for (int i = 0; i < 8; ++i) ss += v[i] * v[i];
            ss += __shfl_xor(ss, 1); ss += __shfl_xor(ss, 2); ss += __shfl_xor(ss, 4); ss += __shfl_xor(ss, 8);
            const float r = 1.f / sqrtf(ss * (1.f / 128.f) + EPS);
            const float* gp = A.qk_gain + (size_t)(layer * 8 + gsel[u]) * 128 + sub * 8;
            const f32x4 g0 = *(const f32x4*)gp, g1 = *(const f32x4*)(gp + 4);
            v4u o; o.x = pk2(v[0] * r * g0.x, v[1] * r * g0.y); o.y = pk2(v[2] * r * g0.z, v[3] * r * g0.w);
            o.z = pk2(v[4] * r * g1.x, v[5] * r * g1.y); o.w = pk2(v[6] * r * g1.z, v[7] * r * g1.w);
            if (ok[u]) *(v4u*)pp[u] = o;
        }
    }
}

__device__ __forceinline__ float gelu_tanh(float x) {
    const float u = 0.7978845608028654f * (x + 0.044715f * x * x * x);
    const float e = __expf(2.f * u);
    const float th = 1.f - 2.f / (e + 1.f);
    return 0.5f * x * (1.f + th);
}

__device__ __forceinline__ void compress_item(Frame& F, int layer, int item) {
    const Args& A = *F.a; const bf16* P = WSP(bf16, WS_P);
    const int lane = F.lane, wave = F.wave, fr = lane & 15, fq = lane >> 4;
    const int kv = item & 1, chunk = (item >> 1) & 15, bh = item >> 5, b = bh >> 1, hk = bh & 1;
    const int col0 = (kv ? C_VCA : C_KCA) + hk * 128;
    int n = chunk * 16 + fr; if (n > 254) n = 254;
    const bf16* arow = P + (size_t)(b * T + 16 * n + 4 * wave) * NP + col0 + fq * 8;
    const float* pe = A.cmp_pe + (size_t)((layer * 2 + kv) * 32 + 4 * wave) * 128 + fq * 8;
    const unsigned char* wl = F.ws + WS_W + (size_t)layer * W_LAYER;
    const bf16* w1 = (const bf16*)(wl + W_C1) + (size_t)kv * 128 * 4096 + (size_t)(16 * wave) * 4096 + fr * 32 + fq * 8;
    const bf16* w2 = (const bf16*)(wl + W_C2) + (size_t)(kv * 128 + wave * 16 + fr) * 128 + fq * 8;
    LAS bf16* H1 = (LAS bf16*)F.lds;
    LAS float* part = (LAS float*)(F.lds + 8192);
    LAS float* red = (LAS float*)(F.lds + 16384);
    __syncthreads();
    f32x4 accp[8];
#pragma unroll
    for (int ct = 0; ct < 8; ++ct) accp[ct] = (f32x4){0.f, 0.f, 0.f, 0.f};
#pragma unroll 2
    for (int s16 = 0; s16 < 16; ++s16) {
        const int lt = s16 >> 2, kk = s16 & 3;
        const v4u w = *(const v4u*)(arow + (size_t)lt * NP + kk * 32);
        const f32x4 p0 = *(const f32x4*)(pe + lt * 128 + kk * 32), p1 = *(const f32x4*)(pe + lt * 128 + kk * 32 + 4);
        v4u a; a.x = pk2(bflo(w.x) + p0.x, bfhi(w.x) + p0.y); a.y = pk2(bflo(w.y) + p0.z, bfhi(w.y) + p0.w);
        a.z = pk2(bflo(w.z) + p1.x, bfhi(w.z) + p1.y); a.w = pk2(bflo(w.w) + p1.z, bfhi(w.w) + p1.w);
        const bf16x8 af = __builtin_bit_cast(bf16x8, a);
#pragma unroll
        for (int ct = 0; ct < 8; ++ct) { const bf16x8 bfr = *(const bf16x8*)(w1 + (size_t)s16 * 4096 + ct * 16 * 32);
            accp[ct] = __builtin_amdgcn_mfma_f32_16x16x32_bf16(af, bfr, accp[ct], 0, 0, 0); }
    }
#pragma unroll
    for (int ct = 0; ct < 8; ++ct)
#pragma unroll
        for (int j = 0; j < 4; ++j) red[(wave * 16 + fq * 4 + j) * 132 + ct * 16 + fr] = accp[ct][j];
    __syncthreads();
    f32x4 acc = {0.f, 0.f, 0.f, 0.f};
#pragma unroll
    for (int w = 0; w < 8; ++w)
#pragma unroll
        for (int j = 0; j < 4; ++j) acc[j] += red[(w * 16 + fq * 4 + j) * 132 + wave * 16 + fr];
#pragma unroll
    for (int j = 0; j < 4; ++j) H1[(fq * 4 + j) * 136 + wave * 16 + fr] = (bf16)f2bf(gelu_tanh(acc[j]));
    __syncthreads();
    f32x4 o = {0.f, 0.f, 0.f, 0.f};
#pragma unroll
    for (int ks = 0; ks < 4; ++ks) {
        const bf16x8 af = *(const LAS bf16x8*)(H1 + fr * 136 + ks * 32 + fq * 8);
        const bf16x8 bfr = *(const bf16x8*)(w2 + ks * 32);
        o = __builtin_amdgcn_mfma_f32_16x16x32_bf16(af, bfr, o, 0, 0, 0);
    }
    const int c = wave * 16 + fr, nbase = chunk * 16 + fq * 4;
    if (kv == 0) {
        float ss[4];
#pragma unroll
        for (int j = 0; j < 4; ++j) { float s = o[j] * o[j]; s += __shfl_xor(s, 1); s += __shfl_xor(s, 2); s += __shfl_xor(s, 4); s += __shfl_xor(s, 8); ss[j] = s; }
        if (fr == 0) {
#pragma unroll
            for (int j = 0; j < 4; ++j) part[wave * 16 + fq * 4 + j] = ss[j]; }
        __syncthreads();
        const float gain = A.qk_gain[(size_t)(layer * 8 + 1) * 128 + c];
        bf16* KC = WSP(bf16, WS_KC);
#pragma unroll
        for (int j = 0; j < 4; ++j) { float tot = 0.f;
#pragma unroll
            for (int w = 0; w < 8; ++w) tot += part[w * 16 + fq * 4 + j];
            const float y = o[j] * (1.f / sqrtf(tot * (1.f / 128.f) + EPS)) * gain;
            KC[(size_t)(bh * 256 + nbase + j) * 128 + c] = (nbase + j < 255) ? (bf16)f2bf(y) : (bf16)0; }
    } else {
        bf16* VCT = WSP(bf16, WS_VCT);
        v2u w; w.x = pk2(o[0], o[1]); w.y = pk2(o[2], (nbase + 3 < 255) ? o[3] : 0.f);
        *(v2u*)(VCT + (size_t)(bh * 128 + c) * 256 + nbase) = w;
    }
}

#define CSB() __builtin_amdgcn_sched_barrier(0)
__device__ __forceinline__ void cmp_loadk2(bf16x8 (&kf)[8], const LAS unsigned char* kcb, int tile0) {
#pragma unroll
    for (int t = 0; t < 2; ++t)
#pragma unroll
        for (int ks = 0; ks < 4; ++ks) kf[t * 4 + ks] = *(const LAS bf16x8*)(kcb + (tile0 + t) * 16 * 272 + ks * 64);
}
__device__ __forceinline__ void cmp_loadv(bf16x8 (&vf)[8], const LAS unsigned char* vcb, int step) {
#pragma unroll
    for (int dt = 0; dt < 8; ++dt) { const v2u lo = *(const LAS v2u*)(vcb + dt * 16 * 528 + 64 * step), hi = *(const LAS v2u*)(vcb + dt * 16 * 528 + 64 * step + 32);
        v4u u; u.x = lo.x; u.y = lo.y; u.z = hi.x; u.w = hi.y; vf[dt] = __builtin_bit_cast(bf16x8, u); }
}
__device__ __forceinline__ void cmp_item(Frame& F, int layer, int item) {
    constexpr float LOG2E_C = 1.4426950408889634f;
    const float m0c = WSP(float, WS_M0)[layer * 8 + 4];
    const bf16* P = WSP(bf16, WS_P); const bf16* KC = WSP(bf16, WS_KC); const bf16* VCT = WSP(bf16, WS_VCT);
    const float* BL = WSP(float, WS_BL); bf16* MIX = WSP(bf16, WS_MIX); u64* SEL = WSP(u64, WS_SEL);
    const int lane = F.lane, wave = F.wave, fr = lane & 15, fq = lane >> 4;
    const int bh = item >> 5, qt = item & 31, b = bh >> 1, hk = bh & 1;
    const int t0 = qt * 128 + wave * 16, t_ = t0 + fr;
    const size_t row = (size_t)b * T + t_;
    const int nlut = qt * 128 + 128;
    const int nmax = (t0 + 15 >= 31) ? ((t0 + 15 - 31) >> 4) : -1;
    float imp[16];
#pragma unroll
    for (int i = 0; i < 16; ++i) imp[i] = 0.f;
    LAS unsigned char* KL = F.lds; LAS unsigned char* VL = F.lds + 69632;
    __syncthreads();
    const int tidv = F.tid;
#pragma unroll
    for (int i = 0; i < 8; ++i) { const int c = tidv + i * 512, r = c >> 4, ch = c & 15;
        *(LAS v4u*)(KL + r * 272 + ch * 16) = *(const v4u*)(KC + (size_t)(bh * 256 + r) * 128 + ch * 8); }
#pragma unroll
    for (int i = 0; i < 8; ++i) { const int c = tidv + i * 512, r = c >> 5, ch = c & 31;
        *(LAS v4u*)(VL + r * 528 + ch * 16) = *(const v4u*)(VCT + (size_t)(bh * 128 + r) * 256 + ch * 8); }
    __syncthreads();
    const LAS unsigned char* kcb = KL + fr * 272 + fq * 16;
    const LAS unsigned char* vcb = VL + fr * 528 + fq * 8;
#pragma unroll 1
    for (int g = 0; g < 3; ++g) {
        const int h = hk * 3 + g;
        int t = t_; asm volatile("" : "+v"(t));
        bf16x8 qf[4];
#pragma unroll
        for (int ks = 0; ks < 4; ++ks) qf[ks] = *(const bf16x8*)(P + row * NP + C_QA + h * 128 + ks * 32 + fq * 8);
        LAS float* bl = (LAS float*)(F.lds + 137216);
        __syncthreads();
        { float lv[8];
#pragma unroll
          for (int u = 0; u < 8; ++u) lv[u] = BL[h * 4096 + ((F.tid + u * 512) & 4095)];
#pragma unroll
          for (int u = 0; u < 8; ++u) { const int i = F.tid + u * 512; if (i < nlut) bl[i] = lv[u] * LOG2E_C - m0c; } }
        __syncthreads();
        float l = 0.f; float impH[16];
#pragma unroll
        for (int i = 0; i < 16; ++i) impH[i] = 0.f;
        f32x4 O[8];
#pragma unroll
        for (int dt = 0; dt < 8; ++dt) O[dt] = (f32x4){0.f, 0.f, 0.f, 0.f};
        float prev3 = 0.f;
#pragma unroll
        for (int kt = 0; kt < 4; ++kt) {
            if (kt * 64 <= nmax) {
                f32x4 S[4]; bf16x8 fa[8], fb[8];
                cmp_loadk2(fa, kcb, kt * 4); CSB();
                cmp_loadk2(fb, kcb, kt * 4 + 2);
#pragma unroll
                for (int t = 0; t < 2; ++t) { S[t] = (f32x4){0.f, 0.f, 0.f, 0.f};
#pragma unroll
                    for (int ks = 0; ks < 4; ++ks) S[t] = __builtin_amdgcn_mfma_f32_16x16x32_bf16(fa[t * 4 + ks], qf[ks], S[t], 0, 0, 0); }
                CSB();
                cmp_loadv(fa, vcb, kt * 2);
#pragma unroll
                for (int t = 0; t < 2; ++t) { S[2 + t] = (f32x4){0.f, 0.f, 0.f, 0.f};
#pragma unroll
                    for (int ks = 0; ks < 4; ++ks) S[2 + t] = __builtin_amdgcn_mfma_f32_16x16x32_bf16(fb[t * 4 + ks], qf[ks], S[2 + t], 0, 0, 0); }
                CSB();
#pragma unroll
                for (int tl = 0; tl < 4; ++tl) {
#pragma unroll
                    for (int j = 0; j < 4; ++j) { const int n = kt * 64 + tl * 16 + fq * 4 + j, dist = t - (16 * n + 31);
                        const float pen = __builtin_bit_cast(float, (unsigned)(dist >> 31) & 0xff800000u);
                        const float e = __builtin_amdgcn_exp2f((S[tl][j] * (SCALE * LOG2E_C) + bl[dist > 0 ? dist : 0]) + pen); S[tl][j] = e; l += e; }
                    const float sh = __shfl(S[tl][3], (lane + 48) & 63);
                    const float nb = (fq == 0) ? prev3 : sh;
                    prev3 = sh;
                    impH[kt * 4 + tl] += 0.5f * nb + S[tl][0] + S[tl][1] + S[tl][2] + 0.5f * S[tl][3];
                }
                CSB();
#pragma unroll
                for (int s2 = 0; s2 < 2; ++s2) {
                    bf16x8 (&cur)[8] = s2 ? fb : fa;
                    if (s2 == 0) cmp_loadv(fb, vcb, kt * 2 + 1);
                    v4u pbu; pbu.x = pk2(S[2 * s2][0], S[2 * s2][1]); pbu.y = pk2(S[2 * s2][2], S[2 * s2][3]); pbu.z = pk2(S[2 * s2 + 1][0], S[2 * s2 + 1][1]); pbu.w = pk2(S[2 * s2 + 1][2], S[2 * s2 + 1][3]);
                    const bf16x8 pb = __builtin_bit_cast(bf16x8, pbu);
#pragma unroll
                    for (int dt = 0; dt < 8; ++dt) O[dt] = __builtin_amdgcn_mfma_f32_16x16x32_bf16(cur[dt], pb, O[dt], 0, 0, 0);
                    CSB();
                }
            }
            __builtin_amdgcn_sched_barrier(0);
        }
        l += __shfl_xor(l, 16); l += __shfl_xor(l, 32);
        const float inv = l > 0.f ? 1.f / l : 0.f;
#pragma unroll
        for (int i = 0; i < 16; ++i) imp[i] += impH[i] * inv;
        const float g0 = sigmoidf_(bf2f(P[row * NP + C_GA + h * 3 + 0])) * inv;
        bf16* op = MIX + row * DM + h * 128 + fq * 4;
#pragma unroll
        for (int dt = 0; dt < 8; ++dt) { v2u w; w.x = pk2(g0 * O[dt][0], g0 * O[dt][1]); w.y = pk2(g0 * O[dt][2], g0 * O[dt][3]); *(v2u*)(op + dt * 16) = w; }
    }
    LAS float* impS = (LAS float*)(F.lds) + wave * (16 * 65) + fr * 65;
    __syncthreads();
    const int t = t_, cur = t >> 6;
#pragma unroll
    for (int tl = 0; tl < 16; ++tl) { const int J = tl * 4 + fq; impS[J] = (J >= 1 && J <= cur - 2) ? imp[tl] : -INFINITY; }
    __syncthreads();
    int cnt[16];
#pragma unroll
    for (int tl = 0; tl < 16; ++tl) cnt[tl] = 0;
#pragma unroll 2
    for (int jp = 0; jp < 64; ++jp) { const float v = impS[jp];
#pragma unroll
        for (int tl = 0; tl < 16; ++tl) { const int J = tl * 4 + fq; cnt[tl] += (v > imp[tl] || (v == imp[tl] && jp < J)) ? 1 : 0; } }
    unsigned mlo = 0u, mhi = 0u;
#pragma unroll
    for (int tl = 0; tl < 16; ++tl) { const int J = tl * 4 + fq;
        const bool sel = (J <= cur) && (cur <= 15 || J == 0 || J >= cur - 1 || cnt[tl] < 13);
        if (sel) { if (tl < 8) mlo |= 1u << J; else mhi |= 1u << (J - 32); } }
    mlo |= __shfl_xor(mlo, 16); mlo |= __shfl_xor(mlo, 32); mhi |= __shfl_xor(mhi, 16); mhi |= __shfl_xor(mhi, 32);
    if (fq == 0) SEL[(size_t)bh * T + t] = ((u64)mhi << 32) | mlo;
}

constexpr int KS_OFF = 0, KS_STRIDE = 288, VS_OFF = 36864, VS_STRIDE = 288, LUT_OFF = 73728, LUT_MAX = 4352, UM_OFF = LUT_OFF + LUT_MAX * 4;
constexpr float LOG2E = 1.4426950408889634f, SC2 = SCALE * LOG2E, LN2 = 0.6931471805599453f;
constexpr int LUT_PAD = 96, LUT_EXTRA = 96;
struct KVSrc { const bf16* k; const bf16* v; int dil, res; };
__device__ __forceinline__ float xmax16(float v) { return fmaxf(v, __shfl_xor(v, 16)); }
__device__ __forceinline__ float xmax32(float v) { return fmaxf(v, __shfl_xor(v, 32)); }
__device__ __forceinline__ float xsum16(float v) { return v + __shfl_xor(v, 16); }
__device__ __forceinline__ float xsum32(float v) { return v + __shfl_xor(v, 32); }

template <int NU = 9>
__device__ __forceinline__ void build_lut(Frame& F, int h, int dil, int maxd, float m0 = 0.f) {
    const float* bl = WSP(float, WS_BL) + h * 4096; LAS float* LUT = (LAS float*)(F.lds + LUT_OFF);
    const int RB = maxd + LUT_EXTRA, n = RB + LUT_PAD;
    __syncthreads();
    float v[NU];
#pragma unroll
    for (int u = 0; u < NU; ++u) { const int d = RB - (F.tid + u * 512), dc = d < 0 ? 0 : (d > maxd ? maxd : d); v[u] = bl[dc * dil]; }
#pragma unroll
    for (int u = 0; u < NU; ++u) { const int i = F.tid + u * 512, d = RB - i; if (i < n) LUT[i] = (d >= 0 && d <= maxd) ? v[u] * LOG2E - m0 : -m0; }
    __syncthreads();
}

#define FSB() __builtin_amdgcn_sched_barrier(0)
__device__ __forceinline__ void loadk2(bf16x8 (&kf)[8], const LAS unsigned char* kb, int p) {
#pragma unroll
    for (int t = 0; t < 2; ++t)
#pragma unroll
        for (int ks = 0; ks < 4; ++ks) kf[t * 4 + ks] = *(const LAS bf16x8*)(kb + (2 * p + t) * 16 * KS_STRIDE + ks * 64);
}
__device__ __forceinline__ void loadv(bf16x8 (&vf)[8], const LAS unsigned char* vb, int s) {
#pragma unroll
    for (int dt = 0; dt < 8; ++dt) { const s16x4 lo = vtr(vb + (32 * s) * VS_STRIDE + dt * 32), hi = vtr(vb + (32 * s + 16) * VS_STRIDE + dt * 32);
        vf[dt] = (bf16x8){lo[0], lo[1], lo[2], lo[3], hi[0], hi[1], hi[2], hi[3]}; }
}
template <int MODE, int NH>
__device__ __forceinline__ void flash_step(f32x4 (&O)[8], float& m, float& l, const bf16x8 (&qf)[4], const LAS unsigned char* kb, const LAS unsigned char* vb,
                                           const LAS float* lp, int d0, bool interior, int W, bool mb0, bool mb1) {
    constexpr int NT = NH * 4, NS = NH * 2;
    f32x4 S[NT];
    bf16x8 fa[8], fb[8];
    loadk2(fa, kb, 0);
    FSB();
#pragma unroll
    for (int p = 0; p < NT / 2; ++p) {
        bf16x8 (&cur)[8] = (p & 1) ? fb : fa; bf16x8 (&nxt)[8] = (p & 1) ? fa : fb;
        if (p + 1 < NT / 2) loadk2(nxt, kb, p + 1); else loadv(nxt, vb, 0);
#pragma unroll
        for (int t = 0; t < 2; ++t) { S[2 * p + t] = (f32x4){0.f, 0.f, 0.f, 0.f};
#pragma unroll
            for (int ks = 0; ks < 4; ++ks) S[2 * p + t] = __builtin_amdgcn_mfma_f32_16x16x32_bf16(cur[t * 4 + ks], qf[ks], S[2 * p + t], 0, 0, 0); }
        FSB();
    }
    float rs0 = 0.f, rs1 = 0.f;
    if (interior) {
#pragma unroll
        for (int tl = 0; tl < NT; ++tl)
#pragma unroll
            for (int j = 0; j < 4; ++j) { const float e = __builtin_amdgcn_exp2f(S[tl][j] * SC2 + lp[tl * 16 + j]); S[tl][j] = e; if (tl < 4) rs0 += e; else rs1 += e; }
    } else {
#pragma unroll
        for (int tl = 0; tl < NT; ++tl)
#pragma unroll
            for (int j = 0; j < 4; ++j) { const int dist = d0 - (tl * 16 + j);
                const int bad = (MODE == 0) ? ((dist >> 31) | ((W - dist) >> 31)) : (dist >> 31);
                const float pen = __builtin_bit_cast(float, (unsigned)bad & 0xff800000u);
                const float e = __builtin_amdgcn_exp2f((S[tl][j] * SC2 + lp[tl * 16 + j]) + pen); S[tl][j] = e; if (tl < 4) rs0 += e; else rs1 += e; }
    }
    if (MODE == 1) { rs0 = mb0 ? rs0 : 0.f; rs1 = mb1 ? rs1 : 0.f; }
    l += rs0 + rs1;
    FSB();
#pragma unroll
    for (int s = 0; s < NS; ++s) {
        bf16x8 (&cur)[8] = (s & 1) ? fb : fa; bf16x8 (&nxt)[8] = (s & 1) ? fa : fb;
        if (s + 1 < NS) loadv(nxt, vb, s + 1);
        v4u pbu; pbu.x = pk2(S[2 * s][0], S[2 * s][1]); pbu.y = pk2(S[2 * s][2], S[2 * s][3]); pbu.z = pk2(S[2 * s + 1][0], S[2 * s + 1][1]); pbu.w = pk2(S[2 * s + 1][2], S[2 * s + 1][3]);
        if (MODE == 1) { const bool mb = (s < 2) ? mb0 : mb1; if (!mb) pbu = (v4u){0u, 0u, 0u, 0u}; }
        const bf16x8 pb = __builtin_bit_cast(bf16x8, pbu);
#pragma unroll
        for (int dt = 0; dt < 8; ++dt) O[dt] = __builtin_amdgcn_mfma_f32_16x16x32_bf16(cur[dt], pb, O[dt], 0, 0, 0);
        FSB();
    }
}

template <int MODE>
__device__ __forceinline__ void flash(Frame& F, f32x4 (&O)[8], float& m, float& l, const bf16x8 (&qf)[4], const KVSrc kv, int q0, int W, int RB, u64 sel, u64 umask, int lut_h = -1, float m0 = 0.f) {
    const int tid = F.tid, lane = F.lane, wave = F.wave, fr = lane & 15, fq = lane >> 4;
    LAS unsigned char* KS = F.lds + KS_OFF; LAS unsigned char* VS = F.lds + VS_OFF; const LAS float* LUT = (const LAS float*)(F.lds + LUT_OFF);
    const int wq0 = q0 + wave * 16, sq = wq0 + fr;
    int kt_lo = 0; const int kt_hi = (q0 + 127) >> 7;
    if (MODE == 0) { const int lo = q0 - W; kt_lo = lo > 0 ? (lo >> 7) : 0; }
#pragma unroll
    for (int dt = 0; dt < 8; ++dt) O[dt] = (f32x4){0.f, 0.f, 0.f, 0.f};
    m = m0; l = 0.f;
    const int r0 = tid >> 4, ch = tid & 15;
    int kt = kt_lo;
    if (MODE == 1) { while (kt <= kt_hi && !((umask >> (2 * kt)) & 3ull)) ++kt; }
    v4u pk[4], pv[4];
    if (kt <= kt_hi) {
#pragma unroll
        for (int i = 0; i < 4; ++i) { const size_t to = (size_t)((kt * 128 + r0 + 32 * i) * kv.dil + kv.res) * NP + ch * 8; pk[i] = *(const v4u*)(kv.k + to); pv[i] = *(const v4u*)(kv.v + to); }
    }
    if (lut_h >= 0) build_lut<1>(F, lut_h, kv.dil, W, m0);
    const LAS unsigned char* kb = KS + fr * KS_STRIDE + fq * 16;
    const LAS unsigned char* vb = VS + (fq * 4 + (fr >> 2)) * VS_STRIDE + (fr & 3) * 8;
    while (kt <= kt_hi) {
        __syncthreads();
#pragma unroll
        for (int i = 0; i < 4; ++i) { *(LAS v4u*)(KS + (r0 + 32 * i) * KS_STRIDE + ch * 16) = pk[i]; *(LAS v4u*)(VS + (r0 + 32 * i) * VS_STRIDE + ch * 16) = pv[i]; }
        __syncthreads();
        int nk = kt + 1;
        if (MODE == 1) { while (nk <= kt_hi && !((umask >> (2 * nk)) & 3ull)) ++nk; }
        if (nk <= kt_hi) {
#pragma unroll
            for (int i = 0; i < 4; ++i) { const size_t to = (size_t)((nk * 128 + r0 + 32 * i) * kv.dil + kv.res) * NP + ch * 8; pk[i] = *(const v4u*)(kv.k + to); pv[i] = *(const v4u*)(kv.v + to); }
        }
        const int key0 = kt * 128;
        const bool mb0 = (MODE == 1) ? (((sel >> (2 * kt)) & 1ull) != 0ull) : true, mb1 = (MODE == 1) ? (((sel >> (2 * kt + 1)) & 1ull) != 0ull) : true;
        bool nh0 = (wq0 + 15 >= key0), nh1 = (wq0 + 15 >= key0 + 64);
        if (MODE == 0) { nh0 = nh0 && (wq0 - (key0 + 63) <= W); nh1 = nh1 && (wq0 - (key0 + 127) <= W); }
        if (MODE == 1) { nh0 = nh0 && (__ballot(mb0) != 0ull); nh1 = nh1 && (__ballot(mb1) != 0ull); }
        if (nh0 && nh1) {
            const int dmin = wq0 - (key0 + 127), dmax = wq0 + 15 - key0;
            const bool interior = (dmin >= 0) && (MODE == 1 || dmax <= W);
            flash_step<MODE, 2>(O, m, l, qf, kb, vb, LUT + (RB - sq + key0 + fq * 4), sq - (key0 + fq * 4), interior, W, mb0, mb1);
        } else if (nh0) {
            const int dmin = wq0 - (key0 + 63), dmax = wq0 + 15 - key0;
            const bool interior = (dmin >= 0) && (MODE == 1 || dmax <= W);
            flash_step<MODE, 1>(O, m, l, qf, kb, vb, LUT + (RB - sq + key0 + fq * 4), sq - (key0 + fq * 4), interior, W, mb0, mb0);
        } else if (nh1) {
            const int dmin = wq0 - (key0 + 127), dmax = wq0 + 15 - (key0 + 64);
            const bool interior = (dmin >= 0) && (MODE == 1 || dmax <= W);
            flash_step<MODE, 1>(O, m, l, qf, kb + 64 * KS_STRIDE, vb + 64 * VS_STRIDE, LUT + (RB - sq + key0 + 64 + fq * 4), sq - (key0 + 64 + fq * 4), interior, W, mb1, mb1);
        }
        kt = nk;
    }
    l = xsum32(xsum16(l));
}
__device__ __forceinline__ void load_q(bf16x8 (&qf)[4], const bf16* qrow, int fq) {
#pragma unroll
    for (int ks = 0; ks < 4; ++ks) qf[ks] = *(const bf16x8*)(qrow + ks * 32 + fq * 8);
}

__device__ __forceinline__ void b_item(Frame& F, int layer, int item) {
    const bf16* P = WSP(bf16, WS_P); bf16* MIX = WSP(bf16, WS_MIX);
    const int fr = F.lane & 15, fq = F.lane >> 4;
    const int qt = item & 31, hb = (item >> 5) & 3, b = item >> 7;
    const int q0 = qt * 128, t = q0 + F.wave * 16 + fr; const size_t row = (size_t)b * T + t;
    const float m0 = WSP(float, WS_M0)[layer * 8 + 2];
    bf16x8 qf[4]; load_q(qf, P + row * NP + C_QB + hb * 128, fq);
    const KVSrc kv{P + (size_t)b * T * NP + C_KB + (hb >> 1) * 128, P + (size_t)b * T * NP + C_VB + (hb >> 1) * 128, 1, 0};
    f32x4 O[8]; float m, l;
    flash<0>(F, O, m, l, qf, kv, q0, 127, 127 + LUT_EXTRA, 0ull, 0ull, 6 + hb, m0);
    const float sink = F.a->sinks[layer * 4 + hb];
    const float inv = 1.f / (l + __builtin_amdgcn_exp2f(sink * LOG2E - m));
    bf16* op = MIX + row * DM + (6 + hb) * 128 + fq * 4;
#pragma unroll
    for (int dt = 0; dt < 8; ++dt) { v2u w; w.x = pk2(O[dt][0] * inv, O[dt][1] * inv); w.y = pk2(O[dt][2] * inv, O[dt][3] * inv); *(v2u*)(op + dt * 16) = w; }
}
__device__ __forceinline__ void c_item(Frame& F, int layer, int item) {
    const bf16* P = WSP(bf16, WS_P); bf16* MIX = WSP(bf16, WS_MIX); float* LSE = WSP(float, WS_LSE);
    const int fr = F.lane & 15, fq = F.lane >> 4;
    const int g = item >> 8, idx = item & 255, j = idx & 1, b = (idx >> 1) & 3, r2 = idx >> 3;
    const int dil = (g == 0) ? 1 : (g == 1 ? 4 : 16), res = r2 % dil, qt = r2 / dil;
    const int q0 = qt * 128, sq = q0 + F.wave * 16 + fr, t = sq * dil + res; const size_t row = (size_t)b * T + t;
    const int hq = 2 * g + j;
    const float m0 = WSP(float, WS_M0)[layer * 8 + 3];
    bf16x8 qf[4]; load_q(qf, P + row * NP + C_QC + hq * 128, fq);
    const KVSrc kv{P + (size_t)b * T * NP + C_KC + g * 128, P + (size_t)b * T * NP + C_VC + g * 128, dil, res};
    f32x4 O[8]; float m, l;
    flash<0>(F, O, m, l, qf, kv, q0, 128, 128 + LUT_EXTRA, 0ull, 0ull, 10 + hq, m0);
    const float inv = 1.f / l;
    bf16* op = MIX + row * DM + (10 + hq) * 128 + fq * 4;
#pragma unroll
    for (int dt = 0; dt < 8; ++dt) { v2u w; w.x = pk2(O[dt][0] * inv, O[dt][1] * inv); w.y = pk2(O[dt][2] * inv, O[dt][3] * inv); *(v2u*)(op + dt * 16) = w; }
    if (fq == 0) LSE[row * 6 + hq] = (m + __log2f(l)) * LN2;
}
__device__ __forceinline__ void a_item(Frame& F, int item, bool dry) {
    const bf16* P = WSP(bf16, WS_P); bf16* MIX = WSP(bf16, WS_MIX); const u64* SEL = WSP(u64, WS_SEL);
    const int lane = F.lane, fr = lane & 15, fq = lane >> 4;
    const int bh6 = item % 24, qt = 31 - item / 24, b = bh6 / 6, h = bh6 % 6, hk = h / 3;
    const int q0 = qt * 128, t = q0 + F.wave * 16 + fr; const size_t row = (size_t)b * T + t;
    const u64 sel = SEL[(size_t)(b * 2 + hk) * T + t];
    unsigned ulo = (unsigned)sel, uhi = (unsigned)(sel >> 32);
#pragma unroll
    for (int o = 1; o < 64; o <<= 1) { ulo |= __shfl_xor(ulo, o); uhi |= __shfl_xor(uhi, o); }
    LAS unsigned* UM = (LAS unsigned*)(F.lds + UM_OFF);
    __syncthreads();
    if (lane == 0) { UM[F.wave * 2] = ulo; UM[F.wave * 2 + 1] = uhi; }
    build_lut(F, h, 1, q0 + 127);
    unsigned alo = 0u, ahi = 0u;
#pragma unroll
    for (int w = 0; w < 8; ++w) { alo |= UM[w * 2]; ahi |= UM[w * 2 + 1]; }
    const u64 umask = ((u64)ahi << 32) | alo;
    bf16x8 qf[4]; load_q(qf, P + row * NP + C_QA + h * 128, fq);
    const bf16* pb = P + (size_t)b * T * NP;
    bf16* op = MIX + row * DM + h * 128 + fq * 4;
    {   f32x4 O1[8]; float m1, l1;
        const KVSrc kv{pb + C_KSA + hk * 128, pb + C_VSA + hk * 128, 1, 0}; flash<1>(F, O1, m1, l1, qf, kv, q0, 0, q0 + 127 + LUT_EXTRA, sel, umask);
        const float g1 = sigmoidf_(bf2f(P[row * NP + C_GA + h * 3 + 1])) / l1;
#pragma unroll
        for (int dt = 0; dt < 8; ++dt) { const v2u c = *(const v2u*)(op + dt * 16);
            v2u w; w.x = pk2(bflo(c.x) + g1 * O1[dt][0], bfhi(c.x) + g1 * O1[dt][1]); w.y = pk2(bflo(c.y) + g1 * O1[dt][2], bfhi(c.y) + g1 * O1[dt][3]); if (!dry) *(v2u*)(op + dt * 16) = w; }
    }
    build_lut(F, h, 1, 511);
    {   f32x4 O2[8]; float m2, l2;
        const KVSrc kv{pb + C_KWA + hk * 128, pb + C_VWA + hk * 128, 1, 0}; flash<0>(F, O2, m2, l2, qf, kv, q0, 511, 511 + LUT_EXTRA, 0ull, 0ull);
        const float g2 = sigmoidf_(bf2f(P[row * NP + C_GA + h * 3 + 2])) / l2;
#pragma unroll
        for (int dt = 0; dt < 8; ++dt) { const v2u c = *(const v2u*)(op + dt * 16);
            v2u w; w.x = pk2(bflo(c.x) + g2 * O2[dt][0], bfhi(c.x) + g2 * O2[dt][1]); w.y = pk2(bflo(c.y) + g2 * O2[dt][2], bfhi(c.y) + g2 * O2[dt][3]); if (!dry) *(v2u*)(op + dt * 16) = w; }
    }
}
typedef float f32x16 __attribute__((ext_vector_type(16)));
constexpr int R32_SLOT = 32768, R32_NSLOT = 4, R32_V = 16384, LUT32_OFF = R32_NSLOT * R32_SLOT, UM32_OFF = LUT32_OFF + LUT_MAX * 4;
__device__ __forceinline__ void k32_load4(bf16x8 (&kf)[4], const LAS unsigned char* slot, const int (&koff)[8], int tile, int c) {
#pragma unroll
    for (int k = 0; k < 4; ++k) kf[k] = *(const LAS bf16x8*)(slot + koff[4 * c + k] + tile * 8192);
}
__device__ __forceinline__ void v32_load(bf16x8 (&vf)[4], const LAS unsigned char* slot, const int (&voff)[4], int ts) {
#pragma unroll
    for (int dt = 0; dt < 4; ++dt) { const s16x4 lo = vtr(slot + R32_V + voff[dt] + (16 * ts) * 256), hi = vtr(slot + R32_V + voff[dt] + (16 * ts + 8) * 256);
        vf[dt] = (bf16x8){lo[0], lo[1], lo[2], lo[3], hi[0], hi[1], hi[2], hi[3]}; }
}
template <int MODE>
__device__ __forceinline__ void flash32_p1(f32x16 (&O)[4], float& m, float& l, f32x16& S0, f32x16& S1, const bf16x8 (&qf)[8], const LAS unsigned char* slot, const int (&koff)[8],
                                           const LAS float* lp, int d0, bool interior, int W, bool mb) {
    const f32x16 Z = {0.f, 0.f, 0.f, 0.f, 0.f, 0.f, 0.f, 0.f, 0.f, 0.f, 0.f, 0.f, 0.f, 0.f, 0.f, 0.f};
    bf16x8 ka[4], kbf[4];
    f32x16 A0, A1;
    k32_load4(ka, slot, koff, 0, 0);
    FSB();
    k32_load4(kbf, slot, koff, 0, 1);
    __builtin_amdgcn_s_setprio(1);
    A0 = __builtin_amdgcn_mfma_f32_32x32x16_bf16(ka[0], qf[0], Z, 0, 0, 0);
#pragma unroll
    for (int k = 1; k < 4; ++k) A0 = __builtin_amdgcn_mfma_f32_32x32x16_bf16(ka[k], qf[k], A0, 0, 0, 0);
    FSB();
    k32_load4(ka, slot, koff, 1, 0);
#pragma unroll
    for (int k = 0; k < 4; ++k) A0 = __builtin_amdgcn_mfma_f32_32x32x16_bf16(kbf[k], qf[4 + k], A0, 0, 0, 0);
    FSB();
    k32_load4(kbf, slot, koff, 1, 1);
    A1 = __builtin_amdgcn_mfma_f32_32x32x16_bf16(ka[0], qf[0], Z, 0, 0, 0);
#pragma unroll
    for (int k = 1; k < 4; ++k) A1 = __builtin_amdgcn_mfma_f32_32x32x16_bf16(ka[k], qf[k], A1, 0, 0, 0);
    FSB();
#pragma unroll
    for (int k = 0; k < 4; ++k) A1 = __builtin_amdgcn_mfma_f32_32x32x16_bf16(kbf[k], qf[4 + k], A1, 0, 0, 0);
    __builtin_amdgcn_s_setprio(0);
    FSB();
    float rs = 0.f;
    if (interior) {
#pragma unroll
        for (int i = 0; i < 16; ++i) { const float e = __builtin_amdgcn_exp2f(A0[i] * SC2 + lp[(i & 3) + 8 * (i >> 2)]); A0[i] = e; rs += e; }
#pragma unroll
        for (int i = 0; i < 16; ++i) { const float e = __builtin_amdgcn_exp2f(A1[i] * SC2 + lp[32 + (i & 3) + 8 * (i >> 2)]); A1[i] = e; rs += e; }
    } else {
#pragma unroll
        for (int i = 0; i < 16; ++i) { const int ko = (i & 3) + 8 * (i >> 2), dist = d0 - ko;
            const int bad = (MODE == 0) ? ((dist >> 31) | ((W - dist) >> 31)) : (dist >> 31);
            const float pen = __builtin_bit_cast(float, (unsigned)bad & 0xff800000u);
            const float e = __builtin_amdgcn_exp2f((A0[i] * SC2 + lp[ko]) + pen); A0[i] = e; rs += e; }
#pragma unroll
        for (int i = 0; i < 16; ++i) { const int ko = 32 + (i & 3) + 8 * (i >> 2), dist = d0 - ko;
            const int bad = (MODE == 0) ? ((dist >> 31) | ((W - dist) >> 31)) : (dist >> 31);
            const float pen = __builtin_bit_cast(float, (unsigned)bad & 0xff800000u);
            const float e = __builtin_amdgcn_exp2f((A1[i] * SC2 + lp[ko]) + pen); A1[i] = e; rs += e; }
    }
    if (MODE == 1) rs = mb ? rs : 0.f;
    l += rs;
    S0 = A0; S1 = A1;
    FSB();
}
template <int MODE>
__device__ __forceinline__ void flash32_p2(f32x16 (&O)[4], const f32x16& S0, const f32x16& S1, const LAS unsigned char* slot, const int (&voff)[4], bool mb) {
    bf16x8 va[4], vbf[4];
    v32_load(va, slot, voff, 0);
    FSB();
    __builtin_amdgcn_s_setprio(1);
#pragma unroll
    for (int ts = 0; ts < 4; ++ts) {
        bf16x8 (&cur)[4] = (ts & 1) ? vbf : va; bf16x8 (&nxt)[4] = (ts & 1) ? va : vbf;
        if (ts + 1 < 4) v32_load(nxt, slot, voff, ts + 1);
        const f32x16& St = (ts >> 1) ? S1 : S0; const int o = 8 * (ts & 1);
        v4u pbu; pbu.x = pk2(St[o], St[o + 1]); pbu.y = pk2(St[o + 2], St[o + 3]); pbu.z = pk2(St[o + 4], St[o + 5]); pbu.w = pk2(St[o + 6], St[o + 7]);
        if (MODE == 1) { if (!mb) pbu = (v4u){0u, 0u, 0u, 0u}; }
        const bf16x8 pb = __builtin_bit_cast(bf16x8, pbu);
#pragma unroll
        for (int dt = 0; dt < 4; ++dt) O[dt] = __builtin_amdgcn_mfma_f32_32x32x16_bf16(cur[dt], pb, O[dt], 0, 0, 0);
        FSB();
    }
    __builtin_amdgcn_s_setprio(0);
}
template <int MODE, bool LAG>
__device__ __forceinline__ void flash32_loop(LAS unsigned char* lds, f32x16 (&O)[4], float& m, float& l, const bf16x8 (&qf)[8], const int (&koff)[8], const int (&voff)[4],
                                             const size_t (&gk)[2], const size_t (&gv)[2], const char* kbase, const char* vbase, size_t tstep, int k0, int k1, int kt_hi,
                                             u64 umask, u64 sel, int wq0, int sq, int RB, int W, const LAS float* LUT, int h, int wave) {
#define R32_ISSUE(ktile_, slot_) do { const char* kp_ = kbase + (size_t)(ktile_) * tstep; const char* vp_ = vbase + (size_t)(ktile_) * tstep; \
        LAS unsigned char* sb_ = lds + (slot_) * R32_SLOT + (2 * wave) * 1024; \
        __builtin_amdgcn_global_load_lds((const unsigned*)(kp_ + gk[0]), (LAS unsigned*)(sb_), 16, 0, 0); \
        __builtin_amdgcn_global_load_lds((const unsigned*)(kp_ + gk[1]), (LAS unsigned*)(sb_ + 1024), 16, 0, 0); \
        __builtin_amdgcn_global_load_lds((const unsigned*)(vp_ + gv[0]), (LAS unsigned*)(sb_ + R32_V), 16, 0, 0); \
        __builtin_amdgcn_global_load_lds((const unsigned*)(vp_ + gv[1]), (LAS unsigned*)(sb_ + R32_V + 1024), 16, 0, 0); } while (0)
#define R32_NEXT(k_) do { ++(k_); if (MODE == 1) { while ((k_) <= kt_hi && !((umask >> (k_)) & 1ull)) ++(k_); } } while (0)
    int slot = 0; bool pneed = false, pmb = false; int pslot = 0;
    f32x16 S0, S1;
#pragma unroll
    for (int i = 0; i < 16; ++i) { S0[i] = 0.f; S1[i] = 0.f; }
    while (k0 <= kt_hi) {
        int k2 = k1; if (k1 <= kt_hi) R32_NEXT(k2);
        if (k1 <= kt_hi) asm volatile("s_waitcnt vmcnt(4)" ::: "memory"); else asm volatile("s_waitcnt vmcnt(0)" ::: "memory");
        __builtin_amdgcn_s_barrier();
        __builtin_amdgcn_sched_barrier(0);
        if (k2 <= kt_hi) { const int s2 = slot + 2 >= R32_NSLOT ? slot + 2 - R32_NSLOT : slot + 2; R32_ISSUE(k2, s2); }
        const int key0 = k0 * 64;
        const bool mb = (MODE == 1) ? (((sel >> k0) & 1ull) != 0ull) : true;
        bool need = (wq0 + 31 >= key0);
        if (MODE == 0) need = need && (wq0 - (key0 + 63) <= W);
        if (MODE == 1) need = need && (__ballot(mb) != 0ull);
        const int dmin = wq0 - (key0 + 63), dmax = wq0 + 31 - key0;
        const bool interior = (dmin >= 0) && (MODE == 1 || dmax <= W);
        if (!LAG) { if (need) { flash32_p1<MODE>(O, m, l, S0, S1, qf, lds + slot * R32_SLOT, koff, LUT + (RB - sq + key0 + 4 * h), sq - (key0 + 4 * h), interior, W, mb);
                                flash32_p2<MODE>(O, S0, S1, lds + slot * R32_SLOT, voff, mb); } }
        else { if (pneed) flash32_p2<MODE>(O, S0, S1, lds + pslot * R32_SLOT, voff, pmb);
               if (need) flash32_p1<MODE>(O, m, l, S0, S1, qf, lds + slot * R32_SLOT, koff, LUT + (RB - sq + key0 + 4 * h), sq - (key0 + 4 * h), interior, W, mb);
               pneed = need; pmb = mb; pslot = slot; }
        k0 = k1; k1 = k2; slot = slot + 1 >= R32_NSLOT ? 0 : slot + 1;
    }
    if (LAG) { if (pneed) flash32_p2<MODE>(O, S0, S1, lds + pslot * R32_SLOT, voff, pmb); }
}
__device__ __forceinline__ void build_lut32(Frame& F, int h, int maxd, float m0);
template <int MODE>
__device__ __forceinline__ void flash32(Frame& F, f32x16 (&O)[4], float& m, float& l, const bf16x8 (&qf)[8], const KVSrc kv, int q0, int W, int RB, u64 sel, u64 umask, int lut_h, int lut_maxd, float m0) {
    const int lane = F.lane, wave = F.wave, r = lane & 31, h = lane >> 5;
    const LAS float* LUT = (const LAS float*)(F.lds + LUT32_OFF);
    const int wq0 = q0 + wave * 32, sq = wq0 + r;
    int kt_lo = 0; const int kt_hi = (q0 + 255) >> 6;
    if (MODE == 0) { const int lo = q0 - W; kt_lo = lo > 0 ? (lo >> 6) : 0; }
#pragma unroll
    for (int dt = 0; dt < 4; ++dt) { for (int i = 0; i < 16; ++i) O[dt][i] = 0.f; }
    l = 0.f;
    int koff[8], voff[4];
#pragma unroll
    for (int ds = 0; ds < 8; ++ds) koff[ds] = r * 256 + ((((ds << 1) | h) ^ (r & 15)) << 4);
    { const int i16 = lane & 15, g = lane >> 4, q = i16 >> 2;
#pragma unroll
      for (int dt = 0; dt < 4; ++dt) voff[dt] = (4 * h + q) * 256 + ((dt ^ q) << 6) + (g & 1) * 32 + (i16 & 3) * 8; }
    size_t gk[2], gv[2];
#pragma unroll
    for (int i = 0; i < 2; ++i) { const int row = 4 * (2 * wave + i) + (lane >> 4), cs = lane & 15;
        gk[i] = (size_t)(row * kv.dil) * NP * 2 + (size_t)((cs ^ (row & 15)) << 4); gv[i] = (size_t)(row * kv.dil) * NP * 2 + (size_t)((cs ^ ((row & 3) << 2)) << 4); }
    const char* kbase = (const char*)kv.k + (size_t)kv.res * NP * 2; const char* vbase = (const char*)kv.v + (size_t)kv.res * NP * 2;
    const size_t tstep = (size_t)64 * kv.dil * NP * 2;
    int k0 = kt_lo - 1; R32_NEXT(k0);
    int k1 = k0; if (k0 <= kt_hi) R32_NEXT(k1);
    __syncthreads();
    { LAS unsigned char* lds = F.lds;
      if (k0 <= kt_hi) R32_ISSUE(k0, 0);
      if (k1 <= kt_hi) R32_ISSUE(k1, 1); }
    build_lut32(F, lut_h, lut_maxd, m0);
    if (wave >= 4) flash32_loop<MODE, true>(F.lds, O, m, l, qf, koff, voff, gk, gv, kbase, vbase, tstep, k0, k1, kt_hi, umask, sel, wq0, sq, RB, W, LUT, h, wave);
    else flash32_loop<MODE, false>(F.lds, O, m, l, qf, koff, voff, gk, gv, kbase, vbase, tstep, k0, k1, kt_hi, umask, sel, wq0, sq, RB, W, LUT, h, wave);
#undef R32_ISSUE
#undef R32_NEXT
    __syncthreads();
    l += __shfl_xor(l, 32);
}
__device__ __forceinline__ void build_lut32(Frame& F, int h, int maxd, float m0) {
    const float* bl = WSP(float, WS_BL) + h * 4096; LAS float* LUT = (LAS float*)(F.lds + LUT32_OFF);
    const int RB = maxd + LUT_EXTRA, n = RB + LUT_PAD;
    __syncthreads();
    float v[9];
#pragma unroll
    for (int u = 0; u < 9; ++u) { const int d = RB - (F.tid + u * 512), dc = d < 0 ? 0 : (d > maxd ? maxd : d); v[u] = bl[dc]; }
#pragma unroll
    for (int u = 0; u < 9; ++u) { const int i = F.tid + u * 512, d = RB - i; if (i < n) LUT[i] = (d >= 0 && d <= maxd) ? v[u] * LOG2E - m0 : -m0; }
    __syncthreads();
}
__device__ __forceinline__ void a_item32(Frame& F, int layer, int item) {
    const bf16* P = WSP(bf16, WS_P); bf16* MIX = WSP(bf16, WS_MIX); const u64* SEL = WSP(u64, WS_SEL);
    const int lane = F.lane, r = lane & 31, hh = lane >> 5;
    const int bh6 = item % 24, qt = 15 - item / 24, b = bh6 / 6, h = bh6 % 6, hk = h / 3;
    const int q0 = qt * 256, t = q0 + F.wave * 32 + r; const size_t row = (size_t)b * T + t;
    const u64 sel = SEL[(size_t)(b * 2 + hk) * T + t];
    unsigned ulo = (unsigned)sel, uhi = (unsigned)(sel >> 32);
#pragma unroll
    for (int o = 1; o < 64; o <<= 1) { ulo |= __shfl_xor(ulo, o); uhi |= __shfl_xor(uhi, o); }
    LAS unsigned* UM = (LAS unsigned*)(F.lds + UM32_OFF);
    __syncthreads();
    if (lane == 0) { UM[F.wave * 2] = ulo; UM[F.wave * 2 + 1] = uhi; }
    const float m0s = WSP(float, WS_M0)[layer * 8 + 0], m0w = WSP(float, WS_M0)[layer * 8 + 1];
    __syncthreads();
    unsigned alo = 0u, ahi = 0u;
#pragma unroll
    for (int w = 0; w < 8; ++w) { alo |= UM[w * 2]; ahi |= UM[w * 2 + 1]; }
    const u64 umask = ((u64)ahi << 32) | alo;
    bf16x8 qf[8];
#pragma unroll
    for (int ks = 0; ks < 8; ++ks) qf[ks] = *(const bf16x8*)(P + row * NP + C_QA + h * 128 + ks * 16 + hh * 8);
    const bf16* pb = P + (size_t)b * T * NP;
    {   f32x16 O1[4]; float m1, l1;
        const KVSrc kv{pb + C_KSA + hk * 128, pb + C_VSA + hk * 128, 1, 0}; flash32<1>(F, O1, m1, l1, qf, kv, q0, 0, q0 + 255 + LUT_EXTRA, sel, umask, h, q0 + 255, m0s);
        int l2 = threadIdx.x & 63; asm volatile("" : "+v"(l2));
        const size_t row2 = (size_t)b * T + q0 + F.wave * 32 + (l2 & 31);
        bf16* op = MIX + row2 * DM + h * 128 + 4 * (l2 >> 5);
        const float g1 = sigmoidf_(bf2f(P[row2 * NP + C_GA + h * 3 + 1])) / l1;
#pragma unroll
        for (int dt = 0; dt < 4; ++dt)
#pragma unroll
            for (int gq = 0; gq < 4; ++gq) { bf16* p = op + dt * 32 + 8 * gq; const v2u c = *(const v2u*)p;
                v2u w; w.x = pk2(bflo(c.x) + g1 * O1[dt][4 * gq], bfhi(c.x) + g1 * O1[dt][4 * gq + 1]); w.y = pk2(bflo(c.y) + g1 * O1[dt][4 * gq + 2], bfhi(c.y) + g1 * O1[dt][4 * gq + 3]); *(v2u*)p = w; }
    }
    {   f32x16 O2[4]; float m2, l2;
        const KVSrc kv{pb + C_KWA + hk * 128, pb + C_VWA + hk * 128, 1, 0}; flash32<0>(F, O2, m2, l2, qf, kv, q0, 511, 511 + LUT_EXTRA, 0ull, 0ull, h, 511, m0w);
        int l3 = threadIdx.x & 63; asm volatile("" : "+v"(l3));
        const size_t row2 = (size_t)b * T + q0 + F.wave * 32 + (l3 & 31);
        bf16* op = MIX + row2 * DM + h * 128 + 4 * (l3 >> 5);
        const float g2 = sigmoidf_(bf2f(P[row2 * NP + C_GA + h * 3 + 2])) / l2;
#pragma unroll
        for (int dt = 0; dt < 4; ++dt)
#pragma unroll
            for (int gq = 0; gq < 4; ++gq) { bf16* p = op + dt * 32 + 8 * gq; const v2u c = *(const v2u*)p;
                v2u w; w.x = pk2(bflo(c.x) + g2 * O2[dt][4 * gq], bfhi(c.x) + g2 * O2[dt][4 * gq + 1]); w.y = pk2(bflo(c.y) + g2 * O2[dt][4 * gq + 2], bfhi(c.y) + g2 * O2[dt][4 * gq + 3]); *(v2u*)p = w; }
    }
}
__device__ __forceinline__ void ccombine_phase(Frame& F) {
    bf16* MIX = WSP(bf16, WS_MIX); const float* LSE = WSP(float, WS_LSE);
    const int gw = F.bid * NWAVES + F.wave, NGW = F.G * NWAVES, sub = F.lane & 15, quad = F.lane >> 4;
    const int total = M * 6 / 4;
    constexpr int U = 4;
    for (int base = gw; base < total; base += NGW * U) {
        v4u w[U]; bf16* pp[U]; float al[U]; bool ok[U];
#pragma unroll
        for (int u = 0; u < U; ++u) {
            const int wi = base + u * NGW; ok[u] = wi < total;
            const int gi = (ok[u] ? wi : gw) * 4 + quad, mrow = gi / 6, hq = gi - mrow * 6, j = hq & 1;
            const float* ls = LSE + (size_t)mrow * 6;
            const float a0 = ls[j], a1 = ls[2 + j], a2 = ls[4 + j], mine = ls[hq];
            const float mx = fmaxf(a0, fmaxf(a1, a2));
            al[u] = __expf(mine - mx) / (__expf(a0 - mx) + __expf(a1 - mx) + __expf(a2 - mx));
            pp[u] = MIX + (size_t)mrow * DM + (10 + hq) * 128 + sub * 8;
            w[u] = *(const v4u*)pp[u];
        }
#pragma unroll
        for (int u = 0; u < U; ++u) { const float alpha = al[u];
            v4u o; o.x = pk2(bflo(w[u].x) * alpha, bfhi(w[u].x) * alpha); o.y = pk2(bflo(w[u].y) * alpha, bfhi(w[u].y) * alpha);
            o.z = pk2(bflo(w[u].z) * alpha, bfhi(w[u].z) * alpha); o.w = pk2(bflo(w[u].w) * alpha, bfhi(w[u].w) * alpha);
            if (ok[u]) *(v4u*)pp[u] = o; }
    }
}

#define XB_TMO      128
#define XB_XCNT(j)  (256  + 64 * (j))
#define XB_XSUB(j)  (1280 + 64 * (j))
#define XB_XGEN(j)  (2304 + 64 * (j))
#define XB_TOP      3328
#define XB_TOPGEN   3392
#define XCD_BAR_WORDS 3456
#define XB_SPIN_CAP (1u << 22)

__device__ __forceinline__ unsigned xb_ld(unsigned* p)              { return __hip_atomic_load(p, __ATOMIC_RELAXED, __HIP_MEMORY_SCOPE_AGENT); }
__device__ __forceinline__ unsigned xb_add(unsigned* p, unsigned v) { return __hip_atomic_fetch_add(p, v, __ATOMIC_RELAXED, __HIP_MEMORY_SCOPE_AGENT); }
__device__ __forceinline__ unsigned xb_xcc_id() { return (unsigned)__builtin_amdgcn_s_getreg((3 << 11) | 20) & 0xFu; }
#define XB_SPIN(cond, bar) do { unsigned _sp = 0; while (cond) { __builtin_amdgcn_s_sleep(1); \
    if ((++_sp & 255u) == 0u) { if (xb_ld(&(bar)[XB_TMO])) break; if (_sp > XB_SPIN_CAP) { atomicAdd(&(bar)[XB_TMO], 1u); break; } } } } while (0)

struct XcdBarrier {
    unsigned* bar; unsigned x;
    volatile LAS unsigned* st;
};

__device__ __forceinline__ XcdBarrier xcd_barrier_post(unsigned* bar, volatile LAS unsigned* st) {
    XcdBarrier b; b.bar = bar; b.x = xb_xcc_id(); b.st = st;
    if (threadIdx.x == 0) (void)xb_add(&bar[XB_XCNT(b.x)], 1u);
    return b;
}
__device__ __forceinline__ void xcd_barrier_complete(unsigned* bar, unsigned x, unsigned& nloc, unsigned& nx) {
    const unsigned G = gridDim.x * gridDim.y * gridDim.z;
    unsigned sum, cnt, mine, sp = 0u;
    for (;;) {
        sum = 0u; cnt = 0u; mine = 0u;
#pragma unroll
        for (unsigned j = 0; j < 16; ++j) { const unsigned c = xb_ld(&bar[XB_XCNT(j)]); sum += c; cnt += (c > 0u) ? 1u : 0u; mine = (j == x) ? c : mine; }
        if (sum == G) break;
        __builtin_amdgcn_s_sleep(1);
        if ((++sp & 255u) == 0u) { if (xb_ld(&bar[XB_TMO])) break; if (sp > XB_SPIN_CAP) { atomicAdd(&bar[XB_TMO], 1u); break; } }
    }
    nloc = mine > 0u ? mine : 1u; nx = cnt > 0u ? cnt : 1u;
}

__device__ __forceinline__ void xcd_barrier(const XcdBarrier& b) {
    asm volatile("s_waitcnt vmcnt(0)" ::: "memory");
    __syncthreads();
    if (threadIdx.x == 0) {
        unsigned* bar = b.bar;
        __builtin_amdgcn_s_waitcnt(0);
        unsigned nloc = b.st[0], nx = b.st[1];
        if (nloc == 0u) { xcd_barrier_complete(bar, b.x, nloc, nx); b.st[0] = nloc; b.st[1] = nx; }
        const unsigned old = xb_add(&bar[XB_XSUB(b.x)], 1u);
        const unsigned gen = old / nloc;
        if (old + 1u == (gen + 1u) * nloc) {
            __builtin_amdgcn_fence(__ATOMIC_RELEASE, "agent");
            asm volatile("s_waitcnt vmcnt(0)" ::: "memory");
            const unsigned og = xb_add(&bar[XB_TOP], 1u);
            const unsigned tg = og / nx;
            if (og + 1u == (tg + 1u) * nx) xb_add(&bar[XB_TOPGEN], 1u);
            else XB_SPIN(xb_ld(&bar[XB_TOPGEN]) == tg, bar);
            __builtin_amdgcn_fence(__ATOMIC_ACQUIRE, "agent");
            xb_add(&bar[XB_XGEN(b.x)], 1u);
            asm volatile("s_waitcnt vmcnt(0)" ::: "memory");
        } else {
            XB_SPIN(xb_ld(&bar[XB_XGEN(b.x)]) == gen, bar);
            __builtin_amdgcn_fence(__ATOMIC_ACQUIRE, "agent");
            asm volatile("s_waitcnt vmcnt(0)" ::: "memory");
        }
    }
    __syncthreads();
}

constexpr int N_PHASES = 19;
template <unsigned PM>
__global__ void __launch_bounds__(512, 2) fwd_kernel(Args args) {
    extern __shared__ __attribute__((aligned(16))) unsigned char lds_raw[];
    Frame F;
    F.lds = (LAS unsigned char*)lds_raw; F.tid = threadIdx.x; F.lane = F.tid & 63; F.wave = __builtin_amdgcn_readfirstlane(F.tid >> 6);
    F.G = gridDim.x; F.bid = blockIdx.x; F.a = &args; F.ws = args.ws;
    const int lo = args.ph_lo, hi = args.ph_hi;
    volatile LAS unsigned* bar_st = (volatile LAS unsigned*)(F.lds + LDS_BYTES - 64);
    if (F.tid < 16) bar_st[F.tid] = 0u;
    __syncthreads();
    XcdBarrier xbar; xbar.bar = (unsigned*)(F.ws + WS_CTL); xbar.x = 0; xbar.st = bar_st;
    if (hi - lo > 2) xbar = xcd_barrier_post((unsigned*)(F.ws + WS_CTL), bar_st);
#define IN(k) (lo <= (k) && (k) < hi)
#define HAS(bit) ((PM >> (bit)) & 1u)
#define OPAQUE_TID() do { int t_ = threadIdx.x; asm volatile("" : "+v"(t_)); F.tid = t_; F.lane = t_ & 63; int b_ = blockIdx.x; asm volatile("" : "+s"(b_)); F.bid = b_; } while (0)
#define SEAM(k) do { if (IN(k) && IN((k) + 1)) { if (lo < 0) cg::this_grid().sync(); else xcd_barrier(xbar); } } while (0)
    if constexpr (HAS(0)) { if (IN(0)) { for (int rep = 0; rep < PR_MISC; ++rep) { OPAQUE_TID(); prologue_phase(F); } } }
#pragma unroll 1
    for (int layer = 0; layer < 2; ++layer) {
        const int pb = 1 + 9 * layer;
        unsigned char* wl = F.ws + WS_W + (size_t)layer * W_LAYER;
        const float* xin = layer == 0 ? args.x : args.out;
        if constexpr (HAS(1)) if (IN(pb + 0)) { OPAQUE_TID(); rms_phase(F, xin, args.norm_attn + layer * DM, WSP(bf16, WS_H)); }
        SEAM(pb + 0);
        if constexpr (HAS(2)) if (IN(pb + 1)) { OPAQUE_TID(); pg8::Gemm g{WSP(bf16, WS_H), (const bf16*)(wl + W_IN), M, NP, DM}; pg8::StaticOrder S; S.init(M, NP, F.G, F.bid);
            EpiStoreBf16 E{WSP(bf16, WS_P), NP, args.qk_gain + (size_t)layer * 8 * 128, (LAS float*)(F.lds + 131072)}; for (int rep = 0; rep < PR_GEMM; ++rep) pg8::gemm_phase<EpiStoreBf16, pg8::StaticOrder, true, true>(F.lds, g, S, E); }
        SEAM(pb + 1);
        if constexpr (HAS(3)) if (IN(pb + 2)) { OPAQUE_TID(); for (int it = F.bid; it < 256; it += F.G) { OPAQUE_TID(); compress_item(F, layer, it); }
            for (int it = F.bid; it < 512 + 768; it += F.G) { OPAQUE_TID(); if (it < 512) b_item(F, layer, it); else c_item(F, layer, it - 512); } }
        SEAM(pb + 2);
        if constexpr (HAS(4)) if (IN(pb + 3)) { OPAQUE_TID(); for (int it = F.bid; it < 256; it += F.G) { OPAQUE_TID(); cmp_item(F, layer, (it & 7) * 32 + (it >> 3)); } }
        SEAM(pb + 3);
        if constexpr (HAS(5)) if (IN(pb + 4)) { OPAQUE_TID();
            if (F.G == 256) { a_item32(F, layer, F.bid); OPAQUE_TID(); if (F.bid >= 128) { a_item32(F, layer, 256 + (255 - F.bid)); OPAQUE_TID(); } }
            else { for (int it = F.bid; it < 384; it += F.G) { OPAQUE_TID(); a_item32(F, layer, it); } OPAQUE_TID(); }
            ccombine_phase(F); }
        SEAM(pb + 4);
        if constexpr (HAS(6)) if (IN(pb + 5)) { OPAQUE_TID(); pg8::Gemm g{WSP(bf16, WS_MIX), (const bf16*)(wl + W_OUT), M, DM, DM}; pg8::StaticOrder S; S.init(M, DM, F.G, F.bid);
            EpiResidF32 E{xin, args.out, DM}; pg8::gemm_phase<EpiResidF32, pg8::StaticOrder, true, true>(F.lds, g, S, E); }
        SEAM(pb + 5);
        if constexpr (HAS(7)) if (IN(pb + 6)) { OPAQUE_TID(); rms_phase(F, args.out, args.norm_ffn + layer * DM, WSP(bf16, WS_H)); }
        SEAM(pb + 6);
        if constexpr (HAS(8)) if (IN(pb + 7)) { OPAQUE_TID(); pg8::Gemm g{WSP(bf16, WS_H), (const bf16*)(wl + W_GU), M, 2 * FF, DM}; pg8::StaticOrder S; S.init(M, 2 * FF, F.G, F.bid);
            EpiSwiGLU E{WSP(bf16, WS_P), FF}; for (int rep = 0; rep < PR_GEMM; ++rep) pg8::gemm_phase<EpiSwiGLU, pg8::StaticOrder, true, true>(F.lds, g, S, E); }
        SEAM(pb + 7);
        if constexpr (HAS(9)) if (IN(pb + 8)) { OPAQUE_TID(); pg8::Gemm g{WSP(bf16, WS_P), (const bf16*)(wl + W_D), M, DM, FF}; pg8::StaticOrder S; S.init(M, DM, F.G, F.bid);
            EpiResidF32 E{args.out, args.out, DM}; pg8::gemm_phase<EpiResidF32, pg8::StaticOrder, true, true>(F.lds, g, S, E); }
        SEAM(pb + 8);
    }
#undef IN
#undef SEAM
}

extern "C" void kernel_launch(void* const* d_in, const int* in_sizes, int n_in, void* d_out, int out_size, void* d_ws, size_t ws_size, hipStream_t stream) {
    static int grid = 0;
    if (grid == 0) {
        if (n_in != 14 || ws_size < WS_END) { fprintf(stderr, "kernel_launch: unexpected n_in %d / ws_size %zu (need %zu)\n", n_in, ws_size, (size_t)WS_END); grid = -1; return; }
        int dev = 0, cus = 0, per_cu = 0;
        (void)hipGetDevice(&dev); (void)hipDeviceGetAttribute(&cus, hipDeviceAttributeMultiprocessorCount, dev);
#if MK_ONE_LAUNCH
        if (hipFuncSetAttribute((const void*)fwd_kernel<0x3ffu>, hipFuncAttributeMaxDynamicSharedMemorySize, LDS_BYTES) != hipSuccess) { fprintf(stderr, "kernel_launch: hipFuncSetAttribute failed\n"); grid = -1; return; }
        (void)hipOccupancyMaxActiveBlocksPerMultiprocessor(&per_cu, (const void*)fwd_kernel<0x3ffu>, 512, LDS_BYTES);
#else
#define SETATTR_K(kk) if (hipFuncSetAttribute((const void*)fwd_kernel<(1u << kk)>, hipFuncAttributeMaxDynamicSharedMemorySize, LDS_BYTES) != hipSuccess) { fprintf(stderr, "kernel_launch: hipFuncSetAttribute failed\n"); grid = -1; return; }
        SETATTR_K(0) SETATTR_K(1) SETATTR_K(2) SETATTR_K(3) SETATTR_K(4) SETATTR_K(5) SETATTR_K(6) SETATTR_K(7) SETATTR_K(8) SETATTR_K(9)
#undef SETATTR_K
        per_cu = 1;
#endif
        (void)hipGetLastError();
        if (per_cu < 1) per_cu = 1;
        grid = cus * per_cu;
    }
    if (grid < 0) return;
    Args a{};
    a.x = (const float*)d_in[0]; a.norm_attn = (const float*)d_in[1]; a.w_in = (const float*)d_in[2]; a.qk_gain = (const float*)d_in[3];
    a.cmp_pe = (const float*)d_in[4]; a.cmp_w1 = (const float*)d_in[5]; a.cmp_w2 = (const float*)d_in[6]; a.sinks = (const float*)d_in[7];
    a.rel_bias = (const float*)d_in[8]; a.w_out = (const float*)d_in[9]; a.norm_ffn = (const float*)d_in[10]; a.w_gate = (const float*)d_in[11];
    a.w_up = (const float*)d_in[12]; a.w_down = (const float*)d_in[13]; a.out = (float*)d_out; a.ws = (unsigned char*)d_ws;
#if MK_ONE_LAUNCH
    if (hipMemsetAsync((char*)d_ws + WS_CTL, 0, CTL_BYTES, stream) != hipSuccess) { fprintf(stderr, "kernel_launch: memset of the barrier words failed\n"); return; }
    a.ph_lo = 0; a.ph_hi = N_PHASES;
    void* kargs[] = {&a};
    hipError_t e = hipLaunchCooperativeKernel((const void*)fwd_kernel<0x3ffu>, dim3(grid), dim3(512), kargs, LDS_BYTES, stream);
    if (e != hipSuccess) fprintf(stderr, "cooperative launch failed: %s (grid %d)\n", hipGetErrorString(e), grid);
#else
    for (int p = 0; p < N_PHASES; ++p) {
        a.ph_lo = p; a.ph_hi = p + 1;
        const int k = p == 0 ? 0 : 1 + (p - 1) % 9;
        switch (k) {
#define LAUNCH_K(kk) case kk: hipLaunchKernelGGL(fwd_kernel<(1u << kk)>, dim3(grid), dim3(512), LDS_BYTES, stream, a); break;
            LAUNCH_K(0) LAUNCH_K(1) LAUNCH_K(2) LAUNCH_K(3) LAUNCH_K(4) LAUNCH_K(5) LAUNCH_K(6) LAUNCH_K(7) LAUNCH_K(8) LAUNCH_K(9)
#undef LAUNCH_K
        }
    }
#endif
}
```

```cpp
#include <hip/hip_runtime.h>
#include <hip/hip_cooperative_groups.h>
#include <cstdio>
#include <cstdint>
namespace cg = cooperative_groups;

#ifndef PR_GEMM
#define PR_GEMM 1
#endif
#ifndef PR_ATT1
#define PR_ATT1 1
#endif
#ifndef PR_ATT2
#define PR_ATT2 1
#endif
#ifndef PR_MISC
#define PR_MISC 1
#endif
#ifndef MK_ONE_LAUNCH
#define MK_ONE_LAUNCH 1
#endif

namespace pg8 {
#define PG8_LAS __attribute__((address_space(3)))
typedef unsigned short bf16_t;
typedef short bf16x8 __attribute__((ext_vector_type(8)));
typedef float f32x4 __attribute__((ext_vector_type(4)));
typedef unsigned u32x4 __attribute__((ext_vector_type(4)));
constexpr int BM = 256, BK = 64, HALF = 128, HTB = HALF * BK * 2  , STAGE_BYTES = 8 * HTB, NXCD = 8, WGM = 8;

__host__ __device__ __forceinline__ int lds_byte(int r, int c) { const int st = (r >> 4) * 2 + (c >> 5), rr = r & 15, cc = c & 31, ob = rr * 64 + cc * 2; return st * 1024 + (ob ^ (((ob >> 9) & 1) << 5)); }
__host__ __device__ __forceinline__ void stage_rc(int b, int& R, int& C) { const int st = b / 1024, sb = b % 1024, swz = sb ^ (((sb >> 9) & 1) << 5); R = (st >> 1) * 16 + swz / 64; C = (st & 1) * 32 + (swz % 64) / 2; }
__host__ __device__ __forceinline__ int perm32(int rho) { const int n = rho >> 4, i = rho & 15; return 8 * (i >> 2) + 4 * n + (i & 3); }

struct Unit { int pm, pn; };
struct Gemm { const bf16_t* A; const bf16_t* Bt; int M, N, K; };

struct StaticOrder {
    int nM, nN, nwg, G, c;
    __host__ __device__ void init(int M, int N, int G_, int c_) { nM = M / BM; nN = N / BM; nwg = nM * nN; G = G_; c = c_; }
    __host__ __device__ bool next(int i, Unit& u) const {
        const long L = (long)i * G + c; if (L >= nwg) return false;
        int wgid = (int)L; { const int q = nwg / NXCD, r = nwg % NXCD, xcd = wgid % NXCD, off = wgid / NXCD; wgid = (xcd < r ? xcd * (q + 1) : r * (q + 1) + (xcd - r) * q) + off; }
        const int nig = WGM * nN, gid = wgid / nig, fm = gid * WGM, gsz = (nM - fm) < WGM ? (nM - fm) : WGM;
        u.pm = fm + ((wgid % nig) % gsz); u.pn = (wgid % nig) / gsz; return true;
    }
    __device__ __forceinline__ void a_ready(const Unit&) const {}
    __device__ __forceinline__ void done(const Unit&) const {}
};

__device__ __forceinline__ unsigned cvt_pk_bf16(float lo, float hi) { unsigned r; asm volatile("v_cvt_pk_bf16_f32 %0, %1, %2" : "=v"(r) : "v"(lo), "v"(hi)); return r; }
template <class Epi, class Sched, bool ALIGN_EPI = false, bool SP2 = false>
__device__ __forceinline__ void gemm_phase(PG8_LAS unsigned char* lds, const Gemm g, const Sched& S, const Epi& E) {
    int tid_ = threadIdx.x; asm volatile("" : "+v"(tid_));
    const int tid = tid_, wid = __builtin_amdgcn_readfirstlane(tid >> 6), lane = tid & 63, wr = wid >> 2, wc = wid & 3, fr = lane & 15, fq = lane >> 4;
    const int K = g.K, nt = K / BK;
    unsigned voffA[2], voffB[2];
#pragma unroll
    for (int i = 0; i < 2; ++i) { int R, C; stage_rc(tid * 16 + i * 8192, R, C); const int Rb = Epi::PERM ? ((R & ~31) + perm32(R & 31)) : R;
        voffA[i] = (unsigned)(R * K + C) * 2u; voffB[i] = (unsigned)(Rb * K + C) * 2u; }
    const size_t kstep = (size_t)(BK * 2);
    const size_t hstep = (size_t)HALF * K * 2;
    const size_t tstep = 2 * hstep;
    const unsigned ldsw = (unsigned)wid * 1024u;
    const int aoff = lds_byte(wr * 64 + fr, fq * 8), boff = lds_byte(wc * 32 + fr, fq * 8);
#define PG8_SA(b, h) (((b) * 2 + (h)) * HTB)
#define PG8_SB(b, h) ((4 + (b) * 2 + (h)) * HTB)
#define PG8_STAGE(bufoff, gbase, voff) do { _Pragma("unroll") for (int _i = 0; _i < 2; ++_i) \
        __builtin_amdgcn_global_load_lds((const unsigned*)((const char*)(gbase) + (voff)[_i]), (PG8_LAS unsigned*)(lds + (bufoff) + ldsw + _i * 8192), 16, 0, 0); } while (0)
#define PG8_LDA(dst, b, h) do { _Pragma("unroll") for (int m = 0; m < 4; ++m) _Pragma("unroll") for (int k = 0; k < 2; ++k) dst[m][k] = *(const PG8_LAS bf16x8*)(lds + PG8_SA(b, h) + aoff + m * 2048 + k * 1024); } while (0)
#define PG8_LDB(dst, b, h) do { _Pragma("unroll") for (int n = 0; n < 2; ++n) _Pragma("unroll") for (int k = 0; k < 2; ++k) dst[n][k] = *(const PG8_LAS bf16x8*)(lds + PG8_SB(b, h) + boff + n * 2048 + k * 1024); } while (0)
#define PG8_MMA(ai, bj, At, Bt) do { __builtin_amdgcn_s_setprio(1); _Pragma("unroll") for (int m = 0; m < 4; ++m) _Pragma("unroll") for (int n = 0; n < 2; ++n) _Pragma("unroll") for (int k = 0; k < 2; ++k) \
        acc[ai][bj][m][n] = __builtin_amdgcn_mfma_f32_16x16x32_bf16(Bt[n][k], At[m][k], acc[ai][bj][m][n], 0, 0, 0); __builtin_amdgcn_s_setprio(0); } while (0)
#define PG8_WAIT_V(n) asm volatile("s_waitcnt vmcnt(" #n ")" ::: "memory")
#define PG8_WAIT_L(n) asm volatile("s_waitcnt lgkmcnt(" #n ")" ::: "memory")
#define PG8_BAR __builtin_amdgcn_s_barrier()
#define PG8_SCHED __builtin_amdgcn_sched_barrier(0)
    Unit cur, nxt; int ui = 0;
    if (!S.next(0, cur)) return;
    f32x4 acc[2][2][4][2];
#pragma unroll
    for (int a = 0; a < 2; ++a)
#pragma unroll
        for (int b = 0; b < 2; ++b)
#pragma unroll
            for (int m = 0; m < 4; ++m)
#pragma unroll
                for (int n = 0; n < 2; ++n) acc[a][b][m][n] = (f32x4){0.f, 0.f, 0.f, 0.f};
    bf16x8 At[4][2], B0[2][2], B1[2][2];
    const char* cA = (const char*)g.A + (size_t)cur.pm * tstep; const char* cB = (const char*)g.Bt + (size_t)cur.pn * tstep;
    S.a_ready(cur);
    if constexpr (SP2) {
        PG8_STAGE(PG8_SB(0, 0), cB, voffB); PG8_STAGE(PG8_SB(0, 1), cB + hstep, voffB); PG8_STAGE(PG8_SA(0, 0), cA, voffA); PG8_STAGE(PG8_SA(0, 1), cA + hstep, voffA);
        if (wr == 1) PG8_BAR;
        PG8_WAIT_V(2); PG8_BAR;
        PG8_STAGE(PG8_SB(1, 0), cB + kstep, voffB); PG8_STAGE(PG8_SA(1, 0), cA + kstep, voffA); PG8_STAGE(PG8_SB(1, 1), cB + hstep + kstep, voffB);
        PG8_WAIT_V(6); PG8_BAR;
    } else {
        PG8_STAGE(PG8_SB(0, 0), cB, voffB); PG8_STAGE(PG8_SA(0, 0), cA, voffA); PG8_STAGE(PG8_SB(0, 1), cB + hstep, voffB); PG8_STAGE(PG8_SA(0, 1), cA + hstep, voffA);
        if (wr == 1) PG8_BAR;
        PG8_WAIT_V(4); PG8_BAR;
        PG8_STAGE(PG8_SB(1, 0), cB + kstep, voffB); PG8_STAGE(PG8_SA(1, 0), cA + kstep, voffA); PG8_STAGE(PG8_SB(1, 1), cB + hstep + kstep, voffB);
        PG8_WAIT_V(6); PG8_BAR;
    }
    for (;;) {
        const bool has_next = S.next(ui + 1, nxt);
        const char* nA = has_next ? (const char*)g.A + (size_t)nxt.pm * tstep : cA; const char* nB = has_next ? (const char*)g.Bt + (size_t)nxt.pn * tstep : cB;
        for (int t = 0; t < nt; t += 2) {
            const bool last = (t == nt - 2);
            const char* a1 = cA + (size_t)(t + 1) * kstep;
            const char* a2 = last ? nA : cA + (size_t)(t + 2) * kstep; const char* b2 = last ? nB : cB + (size_t)(t + 2) * kstep;
            const char* a3 = a2 + kstep; const char* b3 = b2 + kstep;
            if (last && has_next) S.a_ready(nxt);
            if constexpr (SP2) {
            PG8_LDB(B0, 0, 0); PG8_LDB(B1, 0, 1); PG8_SCHED; PG8_LDA(At, 0, 0); PG8_STAGE(PG8_SA(1, 1), a1 + hstep, voffA);
            PG8_WAIT_V(8); PG8_WAIT_L(0); PG8_BAR; PG8_MMA(0, 0, At, B0); PG8_MMA(0, 1, At, B1); PG8_BAR; PG8_SCHED;
            PG8_LDA(At, 0, 1); PG8_STAGE(PG8_SB(0, 0), b2, voffB); PG8_STAGE(PG8_SB(0, 1), b2 + hstep, voffB); PG8_STAGE(PG8_SA(0, 0), a2, voffA);
            PG8_WAIT_V(8); PG8_WAIT_L(0); PG8_BAR; PG8_MMA(1, 0, At, B0); PG8_MMA(1, 1, At, B1); PG8_BAR; PG8_SCHED;
            PG8_LDB(B0, 1, 0); PG8_LDB(B1, 1, 1); PG8_SCHED; PG8_LDA(At, 1, 0); PG8_STAGE(PG8_SA(0, 1), a2 + hstep, voffA);
            PG8_WAIT_V(8); PG8_WAIT_L(0); PG8_BAR; PG8_MMA(0, 0, At, B0); PG8_MMA(0, 1, At, B1); PG8_BAR; PG8_SCHED;
            PG8_LDA(At, 1, 1); PG8_STAGE(PG8_SB(1, 0), b3, voffB); PG8_STAGE(PG8_SB(1, 1), b3 + hstep, voffB); PG8_STAGE(PG8_SA(1, 0), a3, voffA);
            PG8_WAIT_V(8); PG8_WAIT_L(0); PG8_BAR; PG8_MMA(1, 0, At, B0); PG8_MMA(1, 1, At, B1); PG8_BAR; PG8_SCHED;
            } else {
            PG8_LDB(B0, 0, 0); PG8_SCHED; PG8_LDA(At, 0, 0); PG8_STAGE(PG8_SA(1, 1), a1 + hstep, voffA);
            PG8_WAIT_L(8); PG8_BAR; PG8_WAIT_L(0); PG8_MMA(0, 0, At, B0); PG8_BAR; PG8_SCHED;
            PG8_LDB(B1, 0, 1); PG8_STAGE(PG8_SB(0, 0), b2, voffB);
            PG8_BAR; PG8_WAIT_L(0); PG8_MMA(0, 1, At, B1); PG8_BAR;
            PG8_LDA(At, 0, 1); PG8_STAGE(PG8_SA(0, 0), a2, voffA);
            PG8_BAR; PG8_WAIT_L(0); PG8_MMA(1, 0, At, B0); PG8_BAR; PG8_SCHED;
            PG8_STAGE(PG8_SB(0, 1), b2 + hstep, voffB);
            PG8_WAIT_V(6); PG8_BAR; PG8_MMA(1, 1, At, B1); PG8_BAR;
            PG8_LDB(B0, 1, 0); PG8_SCHED; PG8_LDA(At, 1, 0); PG8_STAGE(PG8_SA(0, 1), a2 + hstep, voffA);
            PG8_WAIT_L(8); PG8_BAR; PG8_WAIT_L(0); PG8_MMA(0, 0, At, B0); PG8_BAR; PG8_SCHED;
            PG8_LDB(B1, 1, 1); PG8_STAGE(PG8_SB(1, 0), b3, voffB);
            PG8_BAR; PG8_WAIT_L(0); PG8_MMA(0, 1, At, B1); PG8_BAR;
            PG8_LDA(At, 1, 1); PG8_STAGE(PG8_SA(1, 0), a3, voffA);
            PG8_BAR; PG8_WAIT_L(0); PG8_MMA(1, 0, At, B0); PG8_BAR; PG8_SCHED;
            PG8_STAGE(PG8_SB(1, 1), b3 + hstep, voffB);
            PG8_WAIT_V(6); PG8_BAR; PG8_MMA(1, 1, At, B1); PG8_BAR;
            }
        }
        if constexpr (ALIGN_EPI) { if (wr == 0) PG8_BAR; }
        if constexpr (!Epi::AFTER_DRAIN) { E(acc, cur, wr, wc, fr, fq); S.done(cur); }
        if (!has_next) break;
#pragma unroll
        for (int a = 0; a < 2; ++a)
#pragma unroll
            for (int b = 0; b < 2; ++b)
#pragma unroll
                for (int m = 0; m < 4; ++m)
#pragma unroll
                    for (int n = 0; n < 2; ++n) acc[a][b][m][n] = (f32x4){0.f, 0.f, 0.f, 0.f};
        cur = nxt; cA = nA; cB = nB; ++ui;
        if constexpr (ALIGN_EPI) { if (wr == 1) PG8_BAR; }
    }
    PG8_WAIT_V(0);
    if constexpr (!ALIGN_EPI) { if (wr == 0) PG8_BAR; }
    PG8_BAR;
    if constexpr (Epi::AFTER_DRAIN) { E.fused(acc, cur, wr, wc, fr, fq, lds, wid, lane); S.done(cur); }
#undef PG8_SA
#undef PG8_SB
#undef PG8_STAGE
#undef PG8_LDA
#undef PG8_LDB
#undef PG8_MMA
#undef PG8_WAIT_V
#undef PG8_WAIT_L
#undef PG8_BAR
#undef PG8_SCHED
}
}

#define LAS __attribute__((address_space(3)))
typedef unsigned short bf16;
typedef unsigned v4u __attribute__((ext_vector_type(4)));
typedef unsigned v2u __attribute__((ext_vector_type(2)));
typedef float f32x4 __attribute__((ext_vector_type(4)));
typedef short bf16x8 __attribute__((ext_vector_type(8)));
typedef short s16x4 __attribute__((ext_vector_type(4)));
typedef float f32x2_t __attribute__((ext_vector_type(2)));
typedef __bf16 bf16x2_t __attribute__((ext_vector_type(2)));
typedef unsigned long long u64;

constexpr int NB = 4, T = 4096, DM = 2048, M = NB * T, NP = 5120, FF = 5632, NIN = 4882, NWAVES = 8;
constexpr float SCALE = 0.08838834764831845f, EPS = 1e-6f;
constexpr int C_QA = 0, C_KCA = 768, C_VCA = 1024, C_KSA = 1280, C_VSA = 1536, C_KWA = 1792, C_VWA = 2048,
              C_QB = 2304, C_KB = 2816, C_VB = 3072, C_QC = 3328, C_KC = 4096, C_VC = 4480, C_GA = 4864;
constexpr size_t MiB = 1u << 20;
constexpr size_t WS_BL = 0, WS_M0 = 512 * 1024, WS_KC = 1 * MiB, WS_VCT = 1 * MiB + 512 * 1024, WS_SEL = 2 * MiB, WS_LSE = 2 * MiB + 512 * 1024;
constexpr size_t WS_CTL = 3 * MiB, CTL_BYTES = 16384;
constexpr size_t WS_W = 4 * MiB, W_LAYER = 97 * MiB, W_IN = 0, W_OUT = 20 * MiB, W_GU = 28 * MiB, W_D = 72 * MiB, W_C1 = 94 * MiB, W_C2 = 96 * MiB;
constexpr size_t WS_H = 198 * MiB, WS_MIX = 262 * MiB, WS_P = 326 * MiB, WS_END = 502 * MiB;
constexpr int LDS_BYTES = 155648;

__device__ __forceinline__ unsigned f2bf(float f) { unsigned u = __builtin_bit_cast(unsigned, f); return (u + 0x7fffu + ((u >> 16) & 1u)) >> 16; }
__device__ __forceinline__ unsigned pk2(float lo, float hi) { f32x2_t v = {lo, hi}; bf16x2_t b = __builtin_convertvector(v, bf16x2_t); return __builtin_bit_cast(unsigned, b); }
__device__ __forceinline__ float bf2f(unsigned short h) { return __builtin_bit_cast(float, (unsigned)h << 16); }
__device__ __forceinline__ float bflo(unsigned u) { return __builtin_bit_cast(float, u << 16); }
__device__ __forceinline__ float bfhi(unsigned u) { return __builtin_bit_cast(float, u & 0xffff0000u); }
__device__ __forceinline__ float wave_sum(float v) {
#pragma unroll
    for (int o = 1; o < 64; o <<= 1) v += __shfl_xor(v, o);
    return v;
}
__device__ __forceinline__ float sigmoidf_(float x) { return 1.f / (1.f + __expf(-x)); }
__device__ __forceinline__ s16x4 vtr(LAS const unsigned char* p) { typedef short v4i16_t __attribute__((ext_vector_type(4))); return __builtin_bit_cast(s16x4, __builtin_amdgcn_ds_read_tr16_b64_v4i16((LAS v4i16_t*)p)); }

struct Args {
    const float *x, *norm_attn, *w_in, *qk_gain, *cmp_pe, *cmp_w1, *cmp_w2, *sinks, *rel_bias, *w_out, *norm_ffn, *w_gate, *w_up, *w_down;
    float* out; unsigned char* ws; int ph_lo, ph_hi;
};

__device__ __forceinline__ int unit_gain(int u) {
    if (u < 6) return 0; if (u >= 10 && u < 12) return 2; if (u >= 14 && u < 16) return 3; if (u >= 18 && u < 22) return 4;
    if (u >= 22 && u < 24) return 5; if (u >= 26 && u < 32) return 6; if (u >= 32 && u < 35) return 7; return -1;
}
struct EpiStoreBf16 {
    static constexpr bool PERM = true, AFTER_DRAIN = false;
    bf16* O; int ldc; const float* gains; LAS float* ssx;
    __device__ __forceinline__ void operator()(const f32x4 (&acc)[2][2][4][2], const pg8::Unit& u, int wr, int wc, int fr, int fq) const {
        const int row0 = u.pm * 256 + wr * 64 + fr, col0 = u.pn * 256 + wc * 32 + 8 * fq;
        const int g0 = unit_gain(u.pn * 2), g1 = unit_gain(u.pn * 2 + 1);
        float rn[2][4][2];
        if (g0 >= 0 || g1 >= 0) {
#pragma unroll
            for (int ai = 0; ai < 2; ++ai)
#pragma unroll
                for (int m = 0; m < 4; ++m)
#pragma unroll
                    for (int bj = 0; bj < 2; ++bj) { const f32x4 v0 = acc[ai][bj][m][0], v1 = acc[ai][bj][m][1];
                        float ss = (v0[0] * v0[0] + v0[1] * v0[1]) + (v0[2] * v0[2] + v0[3] * v0[3]) + (v1[0] * v1[0] + v1[1] * v1[1]) + (v1[2] * v1[2] + v1[3] * v1[3]);
                        ss += __shfl_xor(ss, 16); ss += __shfl_xor(ss, 32);
                        if (fq == 0) ssx[(((((wr * 2 + ai) * 4 + m) * 2 + bj) * 16 + fr) << 2) + wc] = ss; }
            asm volatile("s_waitcnt lgkmcnt(0)" ::: "memory");
            __builtin_amdgcn_s_barrier();
            __builtin_amdgcn_sched_barrier(0);
#pragma unroll
            for (int ai = 0; ai < 2; ++ai)
#pragma unroll
                for (int m = 0; m < 4; ++m)
#pragma unroll
                    for (int bj = 0; bj < 2; ++bj) { const f32x4 p = *(const LAS f32x4*)(ssx + (((((wr * 2 + ai) * 4 + m) * 2 + bj) * 16 + fr) << 2));
                        const float tot = (p[0] + p[1]) + (p[2] + p[3]);
                        rn[ai][m][bj] = ((bj ? g1 : g0) >= 0) ? 1.f / sqrtf(tot * (1.f / 128.f) + EPS) : 1.f; }
        }
        f32x4 gv[2][2];
#pragma unroll
        for (int bj = 0; bj < 2; ++bj) { const int gi = bj ? g1 : g0;
            if (gi >= 0) { const float* gp = gains + gi * 128 + wc * 32 + 8 * fq; gv[bj][0] = *(const f32x4*)gp; gv[bj][1] = *(const f32x4*)(gp + 4); }
            else { gv[bj][0] = (f32x4){1.f, 1.f, 1.f, 1.f}; gv[bj][1] = gv[bj][0]; } }
#pragma unroll
        for (int ai = 0; ai < 2; ++ai)
#pragma unroll
            for (int m = 0; m < 4; ++m) { bf16* rowp = O + (size_t)(row0 + ai * 128 + m * 16) * ldc + col0;
#pragma unroll
                for (int bj = 0; bj < 2; ++bj) { const float r = (g0 >= 0 || g1 >= 0) ? rn[ai][m][bj] : 1.f;
                    const f32x4 v0 = acc[ai][bj][m][0] * r * gv[bj][0], v1 = acc[ai][bj][m][1] * r * gv[bj][1];
                    v4u w; w.x = pk2(v0[0], v0[1]); w.y = pk2(v0[2], v0[3]); w.z = pk2(v1[0], v1[1]); w.w = pk2(v1[2], v1[3]);
                    *(v4u*)(rowp + bj * 128) = w; } }
    }
};
struct EpiResidF32 {
    static constexpr bool PERM = true, AFTER_DRAIN = false;
    const float* R; float* O; int ldc;
    __device__ __forceinline__ void operator()(const f32x4 (&acc)[2][2][4][2], const pg8::Unit& u, int wr, int wc, int fr, int fq) const {
        const int row0 = u.pm * 256 + wr * 64 + fr, col0 = u.pn * 256 + wc * 32 + 8 * fq;
#pragma unroll
        for (int ai = 0; ai < 2; ++ai)
#pragma unroll
            for (int m = 0; m < 4; ++m) { const size_t off = (size_t)(row0 + ai * 128 + m * 16) * ldc + col0;
#pragma unroll
                for (int bj = 0; bj < 2; ++bj) {
                    const f32x4 r0 = *(const f32x4*)(R + off + bj * 128), r1 = *(const f32x4*)(R + off + bj * 128 + 4);
                    *(f32x4*)(O + off + bj * 128) = r0 + acc[ai][bj][m][0]; *(f32x4*)(O + off + bj * 128 + 4) = r1 + acc[ai][bj][m][1]; } }
    }
};
struct EpiSwiGLU {
    static constexpr bool PERM = true, AFTER_DRAIN = false;
    bf16* O; int ldc;
    __device__ __forceinline__ void operator()(const f32x4 (&acc)[2][2][4][2], const pg8::Unit& u, int wr, int wc, int fr, int fq) const {
        const int row0 = u.pm * 256 + wr * 64 + fr, col0 = u.pn * 128 + wc * 32 + 8 * fq;
#pragma unroll
        for (int ai = 0; ai < 2; ++ai)
#pragma unroll
            for (int m = 0; m < 4; ++m) { bf16* rowp = O + (size_t)(row0 + ai * 128 + m * 16) * ldc + col0;
                float r[8];
#pragma unroll
                for (int n = 0; n < 2; ++n)
#pragma unroll
                    for (int i = 0; i < 4; ++i) { const float g = acc[ai][0][m][n][i], up = acc[ai][1][m][n][i]; r[n * 4 + i] = g * sigmoidf_(g) * up; }
                v4u w; w.x = pk2(r[0], r[1]); w.y = pk2(r[2], r[3]); w.z = pk2(r[4], r[5]); w.w = pk2(r[6], r[7]);
                *(v4u*)rowp = w; }
    }
};

struct Frame {
    LAS unsigned char* lds;
    int tid, lane, wave, G, bid;
    const Args* a;
    unsigned char* ws;
};
#define WSP(T_, off) ((T_*)(F.ws + (off)))

__device__ __forceinline__ int rel_bucket(int d) {
    if (d < 16) return d;
    int b = 16;
    b += (d >= 22); b += (d >= 30); b += (d >= 40); b += (d >= 54); b += (d >= 73); b += (d >= 99); b += (d >= 134); b += (d >= 182);
    b += (d >= 246); b += (d >= 332); b += (d >= 450); b += (d >= 609); b += (d >= 825); b += (d >= 1117); b += (d >= 1513);
    return b;
}

template <int BLK32 = 0>
__device__ __forceinline__ void tr_item(const float* W, int Nsrc, int K, int k0, int sc, bf16* WTrow0, LAS float* scr, int lane) {
    float v[32];
    const float* wp = W + (size_t)(k0 + (lane >> 5)) * Nsrc + (sc >= 0 ? sc : 0);
#pragma unroll
    for (int i = 0; i < 32; ++i) v[i] = wp[(size_t)(2 * i) * Nsrc];
#pragma unroll
    for (int i = 0; i < 32; ++i) { const int kk = 2 * i + (lane >> 5); scr[kk * 33 + (lane & 31)] = sc >= 0 ? v[i] : 0.f; }
    asm volatile("s_waitcnt lgkmcnt(0)" ::: "memory");
    const int c = lane & 7;
#pragma unroll
    for (int j = 0; j < 4; ++j) { const int n = (lane >> 3) + 8 * j; const LAS float* s = scr + (8 * c) * 33 + n;
        v4u o; o.x = pk2(s[0 * 33], s[1 * 33]); o.y = pk2(s[2 * 33], s[3 * 33]); o.z = pk2(s[4 * 33], s[5 * 33]); o.w = pk2(s[6 * 33], s[7 * 33]);
        if (BLK32) *(v4u*)(WTrow0 + ((size_t)((k0 + 8 * c) >> 5) * 128 + n) * 32 + ((k0 + 8 * c) & 31)) = o;
        else *(v4u*)(WTrow0 + (size_t)n * K + k0 + 8 * c) = o; }
    asm volatile("s_waitcnt lgkmcnt(0)" ::: "memory");
}
__device__ __forceinline__ void prologue_phase(Frame& F) {
    const Args& A = *F.a;
    LAS float* scr = (LAS float*)(F.lds + F.wave * 16384);
    const int gw = F.bid * NWAVES + F.wave, NGW = F.G * NWAVES, lane = F.lane;
    constexpr int I_IN = 32 * 160, I_OUT = 32 * 64, I_GU = 32 * 352, I_D = 88 * 64, I_C1 = 2 * 64 * 4, I_C2 = 2 * 2 * 4;
    constexpr int I_LAYER = I_IN + I_OUT + I_GU + I_D + I_C1 + I_C2;
    for (int it = gw; it < 2 * I_LAYER; it += NGW) {
        const int l = it / I_LAYER; int r = it - l * I_LAYER;
        unsigned char* wl = F.ws + WS_W + (size_t)l * W_LAYER;
        if (r < I_IN) { const int kb = r / 160, nb = r % 160, n = nb * 32 + (lane & 31);
            const int sc = n < 2304 ? n : (n < 4864 ? n + 18 : (n < 4882 ? n - 4864 + 2304 : -1));
            tr_item(A.w_in + (size_t)l * DM * NIN, NIN, DM, kb * 64, sc, (bf16*)(wl + W_IN) + (size_t)nb * 32 * DM, scr, lane); continue; }
        r -= I_IN;
        if (r < I_OUT) { const int kb = r / 64, nb = r % 64;
            tr_item(A.w_out + (size_t)l * DM * DM, DM, DM, kb * 64, nb * 32 + (lane & 31), (bf16*)(wl + W_OUT) + (size_t)nb * 32 * DM, scr, lane); continue; }
        r -= I_OUT;
        if (r < I_GU) { const int kb = r / 352, nb = r % 352, r0 = nb * 32, blk = r0 >> 8, half = (r0 >> 7) & 1, w0 = r0 & 127;
            const float* src = (half ? A.w_up : A.w_gate) + (size_t)l * DM * FF;
            tr_item(src, FF, DM, kb * 64, blk * 128 + w0 + (lane & 31), (bf16*)(wl + W_GU) + (size_t)r0 * DM, scr, lane); continue; }
        r -= I_GU;
        if (r < I_D) { const int kb = r / 64, nb = r % 64;
            tr_item(A.w_down + (size_t)l * FF * DM, DM, FF, kb * 64, nb * 32 + (lane & 31), (bf16*)(wl + W_D) + (size_t)nb * 32 * FF, scr, lane); continue; }
        r -= I_D;
        if (r < I_C1) { const int kv = r / 256, r2 = r % 256, kb = r2 / 4, nb = r2 % 4;
            tr_item<1>(A.cmp_w1 + (size_t)(l * 2 + kv) * 4096 * 128, 128, 4096, kb * 64, nb * 32 + (lane & 31), (bf16*)(wl + W_C1) + (size_t)kv * 128 * 4096 + (size_t)nb * 32 * 32, scr, lane); continue; }
        r -= I_C1;
        { const int kv = r / 8, r2 = r % 8, kb = r2 / 4, nb = r2 % 4;
            tr_item(A.cmp_w2 + (size_t)(l * 2 + kv) * 128 * 128, 128, 128, kb * 64, nb * 32 + (lane & 31), (bf16*)(wl + W_C2) + (size_t)(kv * 128 + nb * 32) * 128, scr, lane); }
    }
    float* BL = WSP(float, WS_BL);
    for (int i = F.bid * 512 + F.tid; i < 16 * 4096; i += F.G * 512) { const int h = i >> 12, d = i & 4095; BL[i] = A.rel_bias[rel_bucket(d) * 16 + h]; }
    if (F.bid == 0 && F.wave == 0) {
        float bm = 0.f;
#pragma unroll
        for (int i = 0; i < 8; ++i) bm = fmaxf(bm, fabsf(A.rel_bias[lane + 64 * i]));
#pragma unroll
        for (int o = 1; o < 64; o <<= 1) bm = fmaxf(bm, __shfl_xor(bm, o));
        for (int l = 0; l < 2; ++l) {
            float g[8];
#pragma unroll
            for (int i = 0; i < 8; ++i) { const float* gp = A.qk_gain + (size_t)(l * 8 + i) * 128; float v = fmaxf(fabsf(gp[lane]), fabsf(gp[lane + 64]));
#pragma unroll
                for (int o = 1; o < 64; o <<= 1) v = fmaxf(v, __shfl_xor(v, o));
                g[i] = v; }
            if (lane == 0) { float* M0 = WSP(float, WS_M0) + l * 8;
                const float c = 128.f * SCALE * 1.4426950408889634f, bb = bm * 1.4426950408889634f + 1.f;
                M0[0] = fminf(c * g[0] * g[2] + bb, 100.f); M0[1] = fminf(c * g[0] * g[3] + bb, 100.f); M0[2] = fminf(c * g[4] * g[5] + bb, 100.f);
                M0[3] = fminf(c * g[6] * g[7] + bb, 100.f); M0[4] = fminf(c * g[0] * g[1] + bb, 100.f); }
        }
    }
}

__device__ __forceinline__ void rms_phase(Frame& F, const float* x, const float* g, bf16* out) {
    const int gw = F.bid * NWAVES + F.wave, NGW = F.G * NWAVES, lane = F.lane;
    f32x4 gv[8];
#pragma unroll
    for (int j = 0; j < 8; ++j) gv[j] = ((const f32x4*)g)[lane + 64 * j];
    for (int m = gw; m < M; m += NGW) {
        const f32x4* xr = (const f32x4*)(x + (size_t)m * DM) + lane;
        f32x4 v[8]; float ss = 0.f;
#pragma unroll
        for (int j = 0; j < 8; ++j) { v[j] = xr[64 * j]; ss += (v[j].x * v[j].x + v[j].y * v[j].y) + (v[j].z * v[j].z + v[j].w * v[j].w); }
        const float r = 1.f / sqrtf(wave_sum(ss) * (1.f / DM) + EPS);
        v2u* o8 = (v2u*)(out + (size_t)m * DM) + lane;
#pragma unroll
        for (int j = 0; j < 8; ++j) { v2u w; w.x = pk2(v[j].x * r * gv[j].x, v[j].y * r * gv[j].y); w.y = pk2(v[j].z * r * gv[j].z, v[j].w * r * gv[j].w); o8[64 * j] = w; }
    }
}

__device__ __forceinline__ void qknorm_phase(Frame& F, int layer) {
    const Args& A = *F.a; bf16* P = WSP(bf16, WS_P);
    const int gw = F.bid * NWAVES + F.wave, NGW = F.G * NWAVES, lane = F.lane, sub = lane & 15, quad = lane >> 4;
    const int total = M * 25 / 4;
    constexpr int U = 5;
    for (int base = gw; base < total; base += NGW * U) {
        v4u w[U]; bf16* pp[U]; int gsel[U]; bool ok[U];
#pragma unroll
        for (int u = 0; u < U; ++u) {
            const int wi = base + u * NGW; ok[u] = wi < total;
            const int gi = (ok[u] ? wi : gw) * 4 + quad, m = gi / 25, uu = gi - m * 25;
            int unit, gidx;
            if (uu < 6) { unit = uu; gidx = 0; } else if (uu < 8) { unit = 10 + (uu - 6); gidx = 2; } else if (uu < 10) { unit = 14 + (uu - 8); gidx = 3; }
            else if (uu < 14) { unit = 18 + (uu - 10); gidx = 4; } else if (uu < 16) { unit = 22 + (uu - 14); gidx = 5; } else if (uu < 22) { unit = 26 + (uu - 16); gidx = 6; }
            else { unit = 32 + (uu - 22); gidx = 7; }
            pp[u] = P + (size_t)m * NP + unit * 128 + sub * 8; gsel[u] = gidx;
            w[u] = *(const v4u*)pp[u];
        }
#pragma unroll
        for (int u = 0; u < U; ++u) {
            float v[8] = {bflo(w[u].x), bfhi(w[u].x), bflo(w[u].y), bfhi(w[u].y), bflo(w[u].z), bfhi(w[u].z), bflo(w[u].w), bfhi(w[u].w)};
            float ss = 0.f;
#pragma unroll
            for (int i = 0; i < 8; ++i) ss += v[i] * v[i];
            ss += __shfl_xor(ss, 1); ss += __shfl_xor(ss, 2); ss += __shfl_xor(ss, 4); ss += __shfl_xor(ss, 8);
            const float r = 1.f / sqrtf(ss * (1.f / 128.f) + EPS);
            const float* gp = A.qk_gain + (size_t)(layer * 8 + gsel[u]) * 128 + sub * 8;
            const f32x4 g0 = *(const f32x4*)gp, g1 = *(const f32x4*)(gp + 4);
            v4u o; o.x = pk2(v[0] * r * g0.x, v[1] * r * g0.y); o.y = pk2(v[2] * r * g0.z, v[3] * r * g0.w);
            o.z = pk2(v[4] * r * g1.x, v[5] * r * g1.y); o.w = pk2(v[6] * r * g1.z, v[7] * r * g1.w);
            if (ok[u]) *(v4u*)pp[u] = o;
        }
    }
}

__device__ __forceinline__ float gelu_tanh(float x) {
    const float u = 0.7978845608028654f * (x + 0.044715f * x * x * x);
    const float e = __expf(2.f * u);
    const float th = 1.f - 2.f / (e + 1.f);
    return 0.5f * x * (1.f + th);
}

__device__ __forceinline__ void compress_item(Frame& F, int layer, int item) {
    const Args& A = *F.a; const bf16* P = WSP(bf16, WS_P);
    const int lane = F.lane, wave = F.wave, fr = lane & 15, fq = lane >> 4;
    const int kv = item & 1, chunk = (item >> 1) & 15, bh = item >> 5, b = bh >> 1, hk = bh & 1;
    const int col0 = (kv ? C_VCA : C_KCA) + hk * 128;
    int n = chunk * 16 + fr; if (n > 254) n = 254;
    const bf16* arow = P + (size_t)(b * T + 16 * n + 4 * wave) * NP + col0 + fq * 8;
    const float* pe = A.cmp_pe + (size_t)((layer * 2 + kv) * 32 + 4 * wave) * 128 + fq * 8;
    const unsigned char* wl = F.ws + WS_W + (size_t)layer * W_LAYER;
    const bf16* w1 = (const bf16*)(wl + W_C1) + (size_t)kv * 128 * 4096 + (size_t)(16 * wave) * 4096 + fr * 32 + fq * 8;
    const bf16* w2 = (const bf16*)(wl + W_C2) + (size_t)(kv * 128 + wave * 16 + fr) * 128 + fq * 8;
    LAS bf16* H1 = (LAS bf16*)F.lds;
    LAS float* part = (LAS float*)(F.lds + 8192);
    LAS float* red = (LAS float*)(F.lds + 16384);
    __syncthreads();
    f32x4 accp[8];
#pragma unroll
    for (int ct = 0; ct < 8; ++ct) accp[ct] = (f32x4){0.f, 0.f, 0.f, 0.f};
#pragma unroll 2
    for (int s16 = 0; s16 < 16; ++s16) {
        const int lt = s16 >> 2, kk = s16 & 3;
        const v4u w = *(const v4u*)(arow + (size_t)lt * NP + kk * 32);
        const f32x4 p0 = *(const f32x4*)(pe + lt * 128 + kk * 32), p1 = *(const f32x4*)(pe + lt * 128 + kk * 32 + 4);
        v4u a; a.x = pk2(bflo(w.x) + p0.x, bfhi(w.x) + p0.y); a.y = pk2(bflo(w.y) + p0.z, bfhi(w.y) + p0.w);
        a.z = pk2(bflo(w.z) + p1.x, bfhi(w.z) + p1.y); a.w = pk2(bflo(w.w) + p1.z, bfhi(w.w) + p1.w);
        const bf16x8 af = __builtin_bit_cast(bf16x8, a);
#pragma unroll
        for (int ct = 0; ct < 8; ++ct) { const bf16x8 bfr = *(const bf16x8*)(w1 + (size_t)s16 * 4096 + ct * 16 * 32);
            accp[ct] = __builtin_amdgcn_mfma_f32_16x16x32_bf16(af, bfr, accp[ct], 0, 0, 0); }
    }
#pragma unroll
    for (int ct = 0; ct < 8; ++ct)
#pragma unroll
        for (int j = 0; j < 4; ++j) red[(wave * 16 + fq * 4 + j) * 132 + ct * 16 + fr] = accp[ct][j];
    __syncthreads();
    f32x4 acc = {0.f, 0.f, 0.f, 0.f};
#pragma unroll
    for (int w = 0; w < 8; ++w)
#pragma unroll
        for (int j = 0; j < 4; ++j) acc[j] += red[(w * 16 + fq * 4 + j) * 132 + wave * 16 + fr];
#pragma unroll
    for (int j = 0; j < 4; ++j) H1[(fq * 4 + j) * 136 + wave * 16 + fr] = (bf16)f2bf(gelu_tanh(acc[j]));
    __syncthreads();
    f32x4 o = {0.f, 0.f, 0.f, 0.f};
#pragma unroll
    for (int ks = 0; ks < 4; ++ks) {
        const bf16x8 af = *(const LAS bf16x8*)(H1 + fr * 136 + ks * 32 + fq * 8);
        const bf16x8 bfr = *(const bf16x8*)(w2 + ks * 32);
        o = __builtin_amdgcn_mfma_f32_16x16x32_bf16(af, bfr, o, 0, 0, 0);
    }
    const int c = wave * 16 + fr, nbase = chunk * 16 + fq * 4;
    if (kv == 0) {
        float ss[4];
#pragma unroll
        for (int j = 0; j < 4; ++j) { float s = o[j] * o[j]; s += __shfl_xor(s, 1); s += __shfl_xor(s, 2); s += __shfl_xor(s, 4); s += __shfl_xor(s, 8); ss[j] = s; }
        if (fr == 0) {
#pragma unroll
            for (int j = 0; j < 4; ++j) part[wave * 16 + fq * 4 + j] = ss[j]; }
        __syncthreads();
        const float gain = A.qk_gain[(size_t)(layer * 8 + 1) * 128 + c];
        bf16* KC = WSP(bf16, WS_KC);
#pragma unroll
        for (int j = 0; j < 4; ++j) { float tot = 0.f;
#pragma unroll
            for (int w = 0; w < 8; ++w) tot += part[w * 16 + fq * 4 + j];
            const float y = o[j] * (1.f / sqrtf(tot * (1.f / 128.f) + EPS)) * gain;
            KC[(size_t)(bh * 256 + nbase + j) * 128 + c] = (nbase + j < 255) ? (bf16)f2bf(y) : (bf16)0; }
    } else {
        bf16* VCT = WSP(bf16, WS_VCT);
        v2u w; w.x = pk2(o[0], o[1]); w.y = pk2(o[2], (nbase + 3 < 255) ? o[3] : 0.f);
        *(v2u*)(VCT + (size_t)(bh * 128 + c) * 256 + nbase) = w;
    }
}

#define CSB() __builtin_amdgcn_sched_barrier(0)
__device__ __forceinline__ void cmp_loadk2(bf16x8 (&kf)[8], const LAS unsigned char* kcb, int tile0) {
#pragma unroll
    for (int t = 0; t < 2; ++t)
#pragma unroll
        for (int ks = 0; ks < 4; ++ks) kf[t * 4 + ks] = *(const LAS bf16x8*)(kcb + (tile0 + t) * 16 * 272 + ks * 64);
}
__device__ __forceinline__ void cmp_loadv(bf16x8 (&vf)[8], const LAS unsigned char* vcb, int step) {
#pragma unroll
    for (int dt = 0; dt < 8; ++dt) { const v2u lo = *(const LAS v2u*)(vcb + dt * 16 * 528 + 64 * step), hi = *(const LAS v2u*)(vcb + dt * 16 * 528 + 64 * step + 32);
        v4u u; u.x = lo.x; u.y = lo.y; u.z = hi.x; u.w = hi.y; vf[dt] = __builtin_bit_cast(bf16x8, u); }
}
__device__ __forceinline__ void cmp_item(Frame& F, int layer, int item) {
    constexpr float LOG2E_C = 1.4426950408889634f;
    const float m0c = WSP(float, WS_M0)[layer * 8 + 4];
    const bf16* P = WSP(bf16, WS_P); const bf16* KC = WSP(bf16, WS_KC); const bf16* VCT = WSP(bf16, WS_VCT);
    const float* BL = WSP(float, WS_BL); bf16* MIX = WSP(bf16, WS_MIX); u64* SEL = WSP(u64, WS_SEL);
    const int lane = F.lane, wave = F.wave, fr = lane & 15, fq = lane >> 4;
    const int bh = item >> 5, qt = item & 31, b = bh >> 1, hk = bh & 1;
    const int t0 = qt * 128 + wave * 16, t_ = t0 + fr;
    const size_t row = (size_t)b * T + t_;
    const int nlut = qt * 128 + 128;
    const int nmax = (t0 + 15 >= 31) ? ((t0 + 15 - 31) >> 4) : -1;
    float imp[16];
#pragma unroll
    for (int i = 0; i < 16; ++i) imp[i] = 0.f;
    LAS unsigned char* KL = F.lds; LAS unsigned char* VL = F.lds + 69632;
    __syncthreads();
    const int tidv = F.tid;
#pragma unroll
    for (int i = 0; i < 8; ++i) { const int c = tidv + i * 512, r = c >> 4, ch = c & 15;
        *(LAS v4u*)(KL + r * 272 + ch * 16) = *(const v4u*)(KC + (size_t)(bh * 256 + r) * 128 + ch * 8); }
#pragma unroll
    for (int i = 0; i < 8; ++i) { const int c = tidv + i * 512, r = c >> 5, ch = c & 31;
        *(LAS v4u*)(VL + r * 528 + ch * 16) = *(const v4u*)(VCT + (size_t)(bh * 128 + r) * 256 + ch * 8); }
    __syncthreads();
    const LAS unsigned char* kcb = KL + fr * 272 + fq * 16;
    const LAS unsigned char* vcb = VL + fr * 528 + fq * 8;
#pragma unroll 1
    for (int g = 0; g < 3; ++g) {
        const int h = hk * 3 + g;
        int t = t_; asm volatile("" : "+v"(t));
        bf16x8 qf[4];
#pragma unroll
        for (int ks = 0; ks < 4; ++ks) qf[ks] = *(const bf16x8*)(P + row * NP + C_QA + h * 128 + ks * 32 + fq * 8);
        LAS float* bl = (LAS float*)(F.lds + 137216);
        __syncthreads();
        { float lv[8];
#pragma unroll
          for (int u = 0; u < 8; ++u) lv[u] = BL[h * 4096 + ((F.tid + u * 512) & 4095)];
#pragma unroll
          for (int u = 0; u < 8; ++u) { const int i = F.tid + u * 512; if (i < nlut) bl[i] = lv[u] * LOG2E_C - m0c; } }
        __syncthreads();
        float l = 0.f; float impH[16];
#pragma unroll
        for (int i = 0; i < 16; ++i) impH[i] = 0.f;
        f32x4 O[8];
#pragma unroll
        for (int dt = 0; dt < 8; ++dt) O[dt] = (f32x4){0.f, 0.f, 0.f, 0.f};
        float prev3 = 0.f;
#pragma unroll
        for (int kt = 0; kt < 4; ++kt) {
            if (kt * 64 <= nmax) {
                f32x4 S[4]; bf16x8 fa[8], fb[8];
                cmp_loadk2(fa, kcb, kt * 4); CSB();
                cmp_loadk2(fb, kcb, kt * 4 + 2);
#pragma unroll
                for (int t = 0; t < 2; ++t) { S[t] = (f32x4){0.f, 0.f, 0.f, 0.f};
#pragma unroll
                    for (int ks = 0; ks < 4; ++ks) S[t] = __builtin_amdgcn_mfma_f32_16x16x32_bf16(fa[t * 4 + ks], qf[ks], S[t], 0, 0, 0); }
                CSB();
                cmp_loadv(fa, vcb, kt * 2);
#pragma unroll
                for (int t = 0; t < 2; ++t) { S[2 + t] = (f32x4){0.f, 0.f, 0.f, 0.f};
#pragma unroll
                    for (int ks = 0; ks < 4; ++ks) S[2 + t] = __builtin_amdgcn_mfma_f32_16x16x32_bf16(fb[t * 4 + ks], qf[ks], S[2 + t], 0, 0, 0); }
                CSB();
#pragma unroll
                for (int tl = 0; tl < 4; ++tl) {
#pragma unroll
                    for (int j = 0; j < 4; ++j) { const int n = kt * 64 + tl * 16 + fq * 4 + j, dist = t - (16 * n + 31);
                        const float pen = __builtin_bit_cast(float, (unsigned)(dist >> 31) & 0xff800000u);
                        const float e = __builtin_amdgcn_exp2f((S[tl][j] * (SCALE * LOG2E_C) + bl[dist > 0 ? dist : 0]) + pen); S[tl][j] = e; l += e; }
                    const float sh = __shfl(S[tl][3], (lane + 48) & 63);
                    const float nb = (fq == 0) ? prev3 : sh;
                    prev3 = sh;
                    impH[kt * 4 + tl] += 0.5f * nb + S[tl][0] + S[tl][1] + S[tl][2] + 0.5f * S[tl][3];
                }
                CSB();
#pragma unroll
                for (int s2 = 0; s2 < 2; ++s2) {
                    bf16x8 (&cur)[8] = s2 ? fb : fa;
                    if (s2 == 0) cmp_loadv(fb, vcb, kt * 2 + 1);
                    v4u pbu; pbu.x = pk2(S[2 * s2][0], S[2 * s2][1]); pbu.y = pk2(S[2 * s2][2], S[2 * s2][3]); pbu.z = pk2(S[2 * s2 + 1][0], S[2 * s2 + 1][1]); pbu.w = pk2(S[2 * s2 + 1][2], S[2 * s2 + 1][3]);
                    const bf16x8 pb = __builtin_bit_cast(bf16x8, pbu);
#pragma unroll
                    for (int dt = 0; dt < 8; ++dt) O[dt] = __builtin_amdgcn_mfma_f32_16x16x32_bf16(cur[dt], pb, O[dt], 0, 0, 0);
                    CSB();
                }
            }
            __builtin_amdgcn_sched_barrier(0);
        }
        l += __shfl_xor(l, 16); l += __shfl_xor(l, 32);
        const float inv = l > 0.f ? 1.f / l : 0.f;
#pragma unroll
        for (int i = 0; i < 16; ++i) imp[i] += impH[i] * inv;
        const float g0 = sigmoidf_(bf2f(P[row * NP + C_GA + h * 3 + 0])) * inv;
        bf16* op = MIX + row * DM + h * 128 + fq * 4;
#pragma unroll
        for (int dt = 0; dt < 8; ++dt) { v2u w; w.x = pk2(g0 * O[dt][0], g0 * O[dt][1]); w.y = pk2(g0 * O[dt][2], g0 * O[dt][3]); *(v2u*)(op + dt * 16) = w; }
    }
    LAS float* impS = (LAS float*)(F.lds) + wave * (16 * 65) + fr * 65;
    __syncthreads();
    const int t = t_, cur = t >> 6;
#pragma unroll
    for (int tl = 0; tl < 16; ++tl) { const int J = tl * 4 + fq; impS[J] = (J >= 1 && J <= cur - 2) ? imp[tl] : -INFINITY; }
    __syncthreads();
    int cnt[16];
#pragma unroll
    for (int tl = 0; tl < 16; ++tl) cnt[tl] = 0;
#pragma unroll 2
    for (int jp = 0; jp < 64; ++jp) { const float v = impS[jp];
#pragma unroll
        for (int tl = 0; tl < 16; ++tl) { const int J = tl * 4 + fq; cnt[tl] += (v > imp[tl] || (v == imp[tl] && jp < J)) ? 1 : 0; } }
    unsigned mlo = 0u, mhi = 0u;
#pragma unroll
    for (int tl = 0; tl < 16; ++tl) { const int J = tl * 4 + fq;
        const bool sel = (J <= cur) && (cur <= 15 || J == 0 || J >= cur - 1 || cnt[tl] < 13);
        if (sel) { if (tl < 8) mlo |= 1u << J; else mhi |= 1u << (J - 32); } }
    mlo |= __shfl_xor(mlo, 16); mlo |= __shfl_xor(mlo, 32); mhi |= __shfl_xor(mhi, 16); mhi |= __shfl_xor(mhi, 32);
    if (fq == 0) SEL[(size_t)bh * T + t] = ((u64)mhi << 32) | mlo;
}

constexpr int KS_OFF = 0, KS_STRIDE = 288, VS_OFF = 36864, VS_STRIDE = 288, LUT_OFF = 73728, LUT_MAX = 4352, UM_OFF = LUT_OFF + LUT_MAX * 4;
constexpr float LOG2E = 1.4426950408889634f, SC2 = SCALE * LOG2E, LN2 = 0.6931471805599453f;
constexpr int LUT_PAD = 96, LUT_EXTRA = 96;
struct KVSrc { const bf16* k; const bf16* v; int dil, res; };
__device__ __forceinline__ float xmax16(float v) { return fmaxf(v, __shfl_xor(v, 16)); }
__device__ __forceinline__ float xmax32(float v) { return fmaxf(v, __shfl_xor(v, 32)); }
__device__ __forceinline__ float xsum16(float v) { return v + __shfl_xor(v, 16); }
__device__ __forceinline__ float xsum32(float v) { return v + __shfl_xor(v, 32); }

template <int NU = 9>
__device__ __forceinline__ void build_lut(Frame& F, int h, int dil, int maxd, float m0 = 0.f) {
    const float* bl = WSP(float, WS_BL) + h * 4096; LAS float* LUT = (LAS float*)(F.lds + LUT_OFF);
    const int RB = maxd + LUT_EXTRA, n = RB + LUT_PAD;
    __syncthreads();
    float v[NU];
#pragma unroll
    for (int u = 0; u < NU; ++u) { const int d = RB - (F.tid + u * 512), dc = d < 0 ? 0 : (d > maxd ? maxd : d); v[u] = bl[dc * dil]; }
#pragma unroll
    for (int u = 0; u < NU; ++u) { const int i = F.tid + u * 512, d = RB - i; if (i < n) LUT[i] = (d >= 0 && d <= maxd) ? v[u] * LOG2E - m0 : -m0; }
    __syncthreads();
}

#define FSB() __builtin_amdgcn_sched_barrier(0)
__device__ __forceinline__ void loadk2(bf16x8 (&kf)[8], const LAS unsigned char* kb, int p) {
#pragma unroll
    for (int t = 0; t < 2; ++t)
#pragma unroll
        for (int ks = 0; ks < 4; ++ks) kf[t * 4 + ks] = *(const LAS bf16x8*)(kb + (2 * p + t) * 16 * KS_STRIDE + ks * 64);
}
__device__ __forceinline__ void loadv(bf16x8 (&vf)[8], const LAS unsigned char* vb, int s) {
#pragma unroll
    for (int dt = 0; dt < 8; ++dt) { const s16x4 lo = vtr(vb + (32 * s) * VS_STRIDE + dt * 32), hi = vtr(vb + (32 * s + 16) * VS_STRIDE + dt * 32);
        vf[dt] = (bf16x8){lo[0], lo[1], lo[2], lo[3], hi[0], hi[1], hi[2], hi[3]}; }
}
template <int MODE, int NH>
__device__ __forceinline__ void flash_step(f32x4 (&O)[8], float& m, float& l, const bf16x8 (&qf)[4], const LAS unsigned char* kb, const LAS unsigned char* vb,
                                           const LAS float* lp, int d0, bool interior, int W, bool mb0, bool mb1) {
    constexpr int NT = NH * 4, NS = NH * 2;
    f32x4 S[NT];
    bf16x8 fa[8], fb[8];
    loadk2(fa, kb, 0);
    FSB();
#pragma unroll
    for (int p = 0; p < NT / 2; ++p) {
        bf16x8 (&cur)[8] = (p & 1) ? fb : fa; bf16x8 (&nxt)[8] = (p & 1) ? fa : fb;
        if (p + 1 < NT / 2) loadk2(nxt, kb, p + 1); else loadv(nxt, vb, 0);
#pragma unroll
        for (int t = 0; t < 2; ++t) { S[2 * p + t] = (f32x4){0.f, 0.f, 0.f, 0.f};
#pragma unroll
            for (int ks = 0; ks < 4; ++ks) S[2 * p + t] = __builtin_amdgcn_mfma_f32_16x16x32_bf16(cur[t * 4 + ks], qf[ks], S[2 * p + t], 0, 0, 0); }
        FSB();
    }
    float rs0 = 0.f, rs1 = 0.f;
    if (interior) {
#pragma unroll
        for (int tl = 0; tl < NT; ++tl)
#pragma unroll
            for (int j = 0; j < 4; ++j) { const float e = __builtin_amdgcn_exp2f(S[tl][j] * SC2 + lp[tl * 16 + j]); S[tl][j] = e; if (tl < 4) rs0 += e; else rs1 += e; }
    } else {
#pragma unroll
        for (int tl = 0; tl < NT; ++tl)
#pragma unroll
            for (int j = 0; j < 4; ++j) { const int dist = d0 - (tl * 16 + j);
                const int bad = (MODE == 0) ? ((dist >> 31) | ((W - dist) >> 31)) : (dist >> 31);
                const float pen = __builtin_bit_cast(float, (unsigned)bad & 0xff800000u);
                const float e = __builtin_amdgcn_exp2f((S[tl][j] * SC2 + lp[tl * 16 + j]) + pen); S[tl][j] = e; if (tl < 4) rs0 += e; else rs1 += e; }
    }
    if (MODE == 1) { rs0 = mb0 ? rs0 : 0.f; rs1 = mb1 ? rs1 : 0.f; }
    l += rs0 + rs1;
    FSB();
#pragma unroll
    for (int s = 0; s < NS; ++s) {
        bf16x8 (&cur)[8] = (s & 1) ? fb : fa; bf16x8 (&nxt)[8] = (s & 1) ? fa : fb;
        if (s + 1 < NS) loadv(nxt, vb, s + 1);
        v4u pbu; pbu.x = pk2(S[2 * s][0], S[2 * s][1]); pbu.y = pk2(S[2 * s][2], S[2 * s][3]); pbu.z = pk2(S[2 * s + 1][0], S[2 * s + 1][1]); pbu.w = pk2(S[2 * s + 1][2], S[2 * s + 1][3]);
        if (MODE == 1) { const bool mb = (s < 2) ? mb0 : mb1; if (!mb) pbu = (v4u){0u, 0u, 0u, 0u}; }
        const bf16x8 pb = __builtin_bit_cast(bf16x8, pbu);
#pragma unroll
        for (int dt = 0; dt < 8; ++dt) O[dt] = __builtin_amdgcn_mfma_f32_16x16x32_bf16(cur[dt], pb, O[dt], 0, 0, 0);
        FSB();
    }
}

template <int MODE>
__device__ __forceinline__ void flash(Frame& F, f32x4 (&O)[8], float& m, float& l, const bf16x8 (&qf)[4], const KVSrc kv, int q0, int W, int RB, u64 sel, u64 umask, int lut_h = -1, float m0 = 0.f) {
    const int tid = F.tid, lane = F.lane, wave = F.wave, fr = lane & 15, fq = lane >> 4;
    LAS unsigned char* KS = F.lds + KS_OFF; LAS unsigned char* VS = F.lds + VS_OFF; const LAS float* LUT = (const LAS float*)(F.lds + LUT_OFF);
    const int wq0 = q0 + wave * 16, sq = wq0 + fr;
    int kt_lo = 0; const int kt_hi = (q0 + 127) >> 7;
    if (MODE == 0) { const int lo = q0 - W; kt_lo = lo > 0 ? (lo >> 7) : 0; }
#pragma unroll
    for (int dt = 0; dt < 8; ++dt) O[dt] = (f32x4){0.f, 0.f, 0.f, 0.f};
    m = m0; l = 0.f;
    const int r0 = tid >> 4, ch = tid & 15;
    int kt = kt_lo;
    if (MODE == 1) { while (kt <= kt_hi && !((umask >> (2 * kt)) & 3ull)) ++kt; }
    v4u pk[4], pv[4];
    if (kt <= kt_hi) {
#pragma unroll
        for (int i = 0; i < 4; ++i) { const size_t to = (size_t)((kt * 128 + r0 + 32 * i) * kv.dil + kv.res) * NP + ch * 8; pk[i] = *(const v4u*)(kv.k + to); pv[i] = *(const v4u*)(kv.v + to); }
    }
    if (lut_h >= 0) build_lut<1>(F, lut_h, kv.dil, W, m0);
    const LAS unsigned char* kb = KS + fr * KS_STRIDE + fq * 16;
    const LAS unsigned char* vb = VS + (fq * 4 + (fr >> 2)) * VS_STRIDE + (fr & 3) * 8;
    while (kt <= kt_hi) {
        __syncthreads();
#pragma unroll
        for (int i = 0; i < 4; ++i) { *(LAS v4u*)(KS + (r0 + 32 * i) * KS_STRIDE + ch * 16) = pk[i]; *(LAS v4u*)(VS + (r0 + 32 * i) * VS_STRIDE + ch * 16) = pv[i]; }
        __syncthreads();
        int nk = kt + 1;
        if (MODE == 1) { while (nk <= kt_hi && !((umask >> (2 * nk)) & 3ull)) ++nk; }
        if (nk <= kt_hi) {
#pragma unroll
            for (int i = 0; i < 4; ++i) { const size_t to = (size_t)((nk * 128 + r0 + 32 * i) * kv.dil + kv.res) * NP + ch * 8; pk[i] = *(const v4u*)(kv.k + to); pv[i] = *(const v4u*)(kv.v + to); }
        }
        const int key0 = kt * 128;
        const bool mb0 = (MODE == 1) ? (((sel >> (2 * kt)) & 1ull) != 0ull) : true, mb1 = (MODE == 1) ? (((sel >> (2 * kt + 1)) & 1ull) != 0ull) : true;
        bool nh0 = (wq0 + 15 >= key0), nh1 = (wq0 + 15 >= key0 + 64);
        if (MODE == 0) { nh0 = nh0 && (wq0 - (key0 + 63) <= W); nh1 = nh1 && (wq0 - (key0 + 127) <= W); }
        if (MODE == 1) { nh0 = nh0 && (__ballot(mb0) != 0ull); nh1 = nh1 && (__ballot(mb1) != 0ull); }
        if (nh0 && nh1) {
            const int dmin = wq0 - (key0 + 127), dmax = wq0 + 15 - key0;
            const bool interior = (dmin >= 0) && (MODE == 1 || dmax <= W);
            flash_step<MODE, 2>(O, m, l, qf, kb, vb, LUT + (RB - sq + key0 + fq * 4), sq - (key0 + fq * 4), interior, W, mb0, mb1);
        } else if (nh0) {
            const int dmin = wq0 - (key0 + 63), dmax = wq0 + 15 - key0;
            const bool interior = (dmin >= 0) && (MODE == 1 || dmax <= W);
            flash_step<MODE, 1>(O, m, l, qf, kb, vb, LUT + (RB - sq + key0 + fq * 4), sq - (key0 + fq * 4), interior, W, mb0, mb0);
        } else if (nh1) {
            const int dmin = wq0 - (key0 + 127), dmax = wq0 + 15 - (key0 + 64);
            const bool interior = (dmin >= 0) && (MODE == 1 || dmax <= W);
            flash_step<MODE, 1>(O, m, l, qf, kb + 64 * KS_STRIDE, vb + 64 * VS_STRIDE, LUT + (RB - sq + key0 + 64 + fq * 4), sq - (key0 + 64 + fq * 4), interior, W, mb1, mb1);
        }
        kt = nk;
    }
    l = xsum32(xsum16(l));
}
__device__ __forceinline__ void load_q(bf16x8 (&qf)[4], const bf16* qrow, int fq) {
#pragma unroll
    for (int ks = 0; ks < 4; ++ks) qf[ks] = *(const bf16x8*)(qrow + ks * 32 + fq * 8);
}

__device__ __forceinline__ void b_item(Frame& F, int layer, int item) {
    const bf16* P = WSP(bf16, WS_P); bf16* MIX = WSP(bf16, WS_MIX);
    const int fr = F.lane & 15, fq = F.lane >> 4;
    const int qt = item & 31, hb = (item >> 5) & 3, b = item >> 7;
    const int q0 = qt * 128, t = q0 + F.wave * 16 + fr; const size_t row = (size_t)b * T + t;
    const float m0 = WSP(float, WS_M0)[layer * 8 + 2];
    bf16x8 qf[4]; load_q(qf, P + row * NP + C_QB + hb * 128, fq);
    const KVSrc kv{P + (size_t)b * T * NP + C_KB + (hb >> 1) * 128, P + (size_t)b * T * NP + C_VB + (hb >> 1) * 128, 1, 0};
    f32x4 O[8]; float m, l;
    flash<0>(F, O, m, l, qf, kv, q0, 127, 127 + LUT_EXTRA, 0ull, 0ull, 6 + hb, m0);
    const float sink = F.a->sinks[layer * 4 + hb];
    const float inv = 1.f / (l + __builtin_amdgcn_exp2f(sink * LOG2E - m));
    bf16* op = MIX + row * DM + (6 + hb) * 128 + fq * 4;
#pragma unroll
    for (int dt = 0; dt < 8; ++dt) { v2u w; w.x = pk2(O[dt][0] * inv, O[dt][1] * inv); w.y = pk2(O[dt][2] * inv, O[dt][3] * inv); *(v2u*)(op + dt * 16) = w; }
}
__device__ __forceinline__ void c_item(Frame& F, int layer, int item) {
    const bf16* P = WSP(bf16, WS_P); bf16* MIX = WSP(bf16, WS_MIX); float* LSE = WSP(float, WS_LSE);
    const int fr = F.lane & 15, fq = F.lane >> 4;
    const int g = item >> 8, idx = item & 255, j = idx & 1, b = (idx >> 1) & 3, r2 = idx >> 3;
    const int dil = (g == 0) ? 1 : (g == 1 ? 4 : 16), res = r2 % dil, qt = r2 / dil;
    const int q0 = qt * 128, sq = q0 + F.wave * 16 + fr, t = sq * dil + res; const size_t row = (size_t)b * T + t;
    const int hq = 2 * g + j;
    const float m0 = WSP(float, WS_M0)[layer * 8 + 3];
    bf16x8 qf[4]; load_q(qf, P + row * NP + C_QC + hq * 128, fq);
    const KVSrc kv{P + (size_t)b * T * NP + C_KC + g * 128, P + (size_t)b * T * NP + C_VC + g * 128, dil, res};
    f32x4 O[8]; float m, l;
    flash<0>(F, O, m, l, qf, kv, q0, 128, 128 + LUT_EXTRA, 0ull, 0ull, 10 + hq, m0);
    const float inv = 1.f / l;
    bf16* op = MIX + row * DM + (10 + hq) * 128 + fq * 4;
#pragma unroll
    for (int dt = 0; dt < 8; ++dt) { v2u w; w.x = pk2(O[dt][0] * inv, O[dt][1] * inv); w.y = pk2(O[dt][2] * inv, O[dt][3] * inv); *(v2u*)(op + dt * 16) = w; }
    if (fq == 0) LSE[row * 6 + hq] = (m + __log2f(l)) * LN2;
}
__device__ __forceinline__ void a_item(Frame& F, int item, bool dry) {
    const bf16* P = WSP(bf16, WS_P); bf16* MIX = WSP(bf16, WS_MIX); const u64* SEL = WSP(u64, WS_SEL);
    const int lane = F.lane, fr = lane & 15, fq = lane >> 4;
    const int bh6 = item % 24, qt = 31 - item / 24, b = bh6 / 6, h = bh6 % 6, hk = h / 3;
    const int q0 = qt * 128, t = q0 + F.wave * 16 + fr; const size_t row = (size_t)b * T + t;
    const u64 sel = SEL[(size_t)(b * 2 + hk) * T + t];
    unsigned ulo = (unsigned)sel, uhi = (unsigned)(sel >> 32);
#pragma unroll
    for (int o = 1; o < 64; o <<= 1) { ulo |= __shfl_xor(ulo, o); uhi |= __shfl_xor(uhi, o); }
    LAS unsigned* UM = (LAS unsigned*)(F.lds + UM_OFF);
    __syncthreads();
    if (lane == 0) { UM[F.wave * 2] = ulo; UM[F.wave * 2 + 1] = uhi; }
    build_lut(F, h, 1, q0 + 127);
    unsigned alo = 0u, ahi = 0u;
#pragma unroll
    for (int w = 0; w < 8; ++w) { alo |= UM[w * 2]; ahi |= UM[w * 2 + 1]; }
    const u64 umask = ((u64)ahi << 32) | alo;
    bf16x8 qf[4]; load_q(qf, P + row * NP + C_QA + h * 128, fq);
    const bf16* pb = P + (size_t)b * T * NP;
    bf16* op = MIX + row * DM + h * 128 + fq * 4;
    {   f32x4 O1[8]; float m1, l1;
        const KVSrc kv{pb + C_KSA + hk * 128, pb + C_VSA + hk * 128, 1, 0}; flash<1>(F, O1, m1, l1, qf, kv, q0, 0, q0 + 127 + LUT_EXTRA, sel, umask);
        const float g1 = sigmoidf_(bf2f(P[row * NP + C_GA + h * 3 + 1])) / l1;
#pragma unroll
        for (int dt = 0; dt < 8; ++dt) { const v2u c = *(const v2u*)(op + dt * 16);
            v2u w; w.x = pk2(bflo(c.x) + g1 * O1[dt][0], bfhi(c.x) + g1 * O1[dt][1]); w.y = pk2(bflo(c.y) + g1 * O1[dt][2], bfhi(c.y) + g1 * O1[dt][3]); if (!dry) *(v2u*)(op + dt * 16) = w; }
    }
    build_lut(F, h, 1, 511);
    {   f32x4 O2[8]; float m2, l2;
        const KVSrc kv{pb + C_KWA + hk * 128, pb + C_VWA + hk * 128, 1, 0}; flash<0>(F, O2, m2, l2, qf, kv, q0, 511, 511 + LUT_EXTRA, 0ull, 0ull);
        const float g2 = sigmoidf_(bf2f(P[row * NP + C_GA + h * 3 + 2])) / l2;
#pragma unroll
        for (int dt = 0; dt < 8; ++dt) { const v2u c = *(const v2u*)(op + dt * 16);
            v2u w; w.x = pk2(bflo(c.x) + g2 * O2[dt][0], bfhi(c.x) + g2 * O2[dt][1]); w.y = pk2(bflo(c.y) + g2 * O2[dt][2], bfhi(c.y) + g2 * O2[dt][3]); if (!dry) *(v2u*)(op + dt * 16) = w; }
    }
}
typedef float f32x16 __attribute__((ext_vector_type(16)));
constexpr int R32_SLOT = 32768, R32_NSLOT = 4, R32_V = 16384, LUT32_OFF = R32_NSLOT * R32_SLOT, UM32_OFF = LUT32_OFF + LUT_MAX * 4;
__device__ __forceinline__ void k32_load4(bf16x8 (&kf)[4], const LAS unsigned char* slot, const int (&koff)[8], int tile, int c) {
#pragma unroll
    for (int k = 0; k < 4; ++k) kf[k] = *(const LAS bf16x8*)(slot + koff[4 * c + k] + tile * 8192);
}
__device__ __forceinline__ void v32_load(bf16x8 (&vf)[4], const LAS unsigned char* slot, const int (&voff)[4], int ts) {
#pragma unroll
    for (int dt = 0; dt < 4; ++dt) { const s16x4 lo = vtr(slot + R32_V + voff[dt] + (16 * ts) * 256), hi = vtr(slot + R32_V + voff[dt] + (16 * ts + 8) * 256);
        vf[dt] = (bf16x8){lo[0], lo[1], lo[2], lo[3], hi[0], hi[1], hi[2], hi[3]}; }
}
template <int MODE>
__device__ __forceinline__ void flash32_p1(f32x16 (&O)[4], float& m, float& l, f32x16& S0, f32x16& S1, const bf16x8 (&qf)[8], const LAS unsigned char* slot, const int (&koff)[8],
                                           const LAS float* lp, int d0, bool interior, int W, bool mb) {
    const f32x16 Z = {0.f, 0.f, 0.f, 0.f, 0.f, 0.f, 0.f, 0.f, 0.f, 0.f, 0.f, 0.f, 0.f, 0.f, 0.f, 0.f};
    bf16x8 ka[4], kbf[4];
    f32x16 A0, A1;
    k32_load4(ka, slot, koff, 0, 0);
    FSB();
    k32_load4(kbf, slot, koff, 0, 1);
    __builtin_amdgcn_s_setprio(1);
    A0 = __builtin_amdgcn_mfma_f32_32x32x16_bf16(ka[0], qf[0], Z, 0, 0, 0);
#pragma unroll
    for (int k = 1; k < 4; ++k) A0 = __builtin_amdgcn_mfma_f32_32x32x16_bf16(ka[k], qf[k], A0, 0, 0, 0);
    FSB();
    k32_load4(ka, slot, koff, 1, 0);
#pragma unroll
    for (int k = 0; k < 4; ++k) A0 = __builtin_amdgcn_mfma_f32_32x32x16_bf16(kbf[k], qf[4 + k], A0, 0, 0, 0);
    FSB();
    k32_load4(kbf, slot, koff, 1, 1);
    A1 = __builtin_amdgcn_mfma_f32_32x32x16_bf16(ka[0], qf[0], Z, 0, 0, 0);
#pragma unroll
    for (int k = 1; k < 4; ++k) A1 = __builtin_amdgcn_mfma_f32_32x32x16_bf16(ka[k], qf[k], A1, 0, 0, 0);
    FSB();
#pragma unroll
    for (int k = 0; k < 4; ++k) A1 = __builtin_amdgcn_mfma_f32_32x32x16_bf16(kbf[k], qf[4 + k], A1, 0, 0, 0);
    __builtin_amdgcn_s_setprio(0);
    FSB();
    float rs = 0.f;
    if (interior) {
#pragma unroll
        for (int i = 0; i < 16; ++i) { const float e = __builtin_amdgcn_exp2f(A0[i] * SC2 + lp[(i & 3) + 8 * (i >> 2)]); A0[i] = e; rs += e; }
#pragma unroll
        for (int i = 0; i < 16; ++i) { const float e = __builtin_amdgcn_exp2f(A1[i] * SC2 + lp[32 + (i & 3) + 8 * (i >> 2)]); A1[i] = e; rs += e; }
    } else {
#pragma unroll
        for (int i = 0; i < 16; ++i) { const int ko = (i & 3) + 8 * (i >> 2), dist = d0 - ko;
            const int bad = (MODE == 0) ? ((dist >> 31) | ((W - dist) >> 31)) : (dist >> 31);
            const float pen = __builtin_bit_cast(float, (unsigned)bad & 0xff800000u);
            const float e = __builtin_amdgcn_exp2f((A0[i] * SC2 + lp[ko]) + pen); A0[i] = e; rs += e; }
#pragma unroll
        for (int i = 0; i < 16; ++i) { const int ko = 32 + (i & 3) + 8 * (i >> 2), dist = d0 - ko;
            const int bad = (MODE == 0) ? ((dist >> 31) | ((W - dist) >> 31)) : (dist >> 31);
            const float pen = __builtin_bit_cast(float, (unsigned)bad & 0xff800000u);
            const float e = __builtin_amdgcn_exp2f((A1[i] * SC2 + lp[ko]) + pen); A1[i] = e; rs += e; }
    }
    if (MODE == 1) rs = mb ? rs : 0.f;
    l += rs;
    S0 = A0; S1 = A1;
    FSB();
}
template <int MODE>
__device__ __forceinline__ void flash32_p2(f32x16 (&O)[4], const f32x16& S0, const f32x16& S1, const LAS unsigned char* slot, const int (&voff)[4], bool mb) {
    bf16x8 va[4], vbf[4];
    v32_load(va, slot, voff, 0);
    FSB();
    __builtin_amdgcn_s_setprio(1);
#pragma unroll
    for (int ts = 0; ts < 4; ++ts) {
        bf16x8 (&cur)[4] = (ts & 1) ? vbf : va; bf16x8 (&nxt)[4] = (ts & 1) ? va : vbf;
        if (ts + 1 < 4) v32_load(nxt, slot, voff, ts + 1);
        const f32x16& St = (ts >> 1) ? S1 : S0; const int o = 8 * (ts & 1);
        v4u pbu; pbu.x = pk2(St[o], St[o + 1]); pbu.y = pk2(St[o + 2], St[o + 3]); pbu.z = pk2(St[o + 4], St[o + 5]); pbu.w = pk2(St[o + 6], St[o + 7]);
        if (MODE == 1) { if (!mb) pbu = (v4u){0u, 0u, 0u, 0u}; }
        const bf16x8 pb = __builtin_bit_cast(bf16x8, pbu);
#pragma unroll
        for (int dt = 0; dt < 4; ++dt) O[dt] = __builtin_amdgcn_mfma_f32_32x32x16_bf16(cur[dt], pb, O[dt], 0, 0, 0);
        FSB();
    }
    __builtin_amdgcn_s_setprio(0);
}
template <int MODE, bool LAG>
__device__ __forceinline__ void flash32_loop(LAS unsigned char* lds, f32x16 (&O)[4], float& m, float& l, const bf16x8 (&qf)[8], const int (&koff)[8], const int (&voff)[4],
                                             const size_t (&gk)[2], const size_t (&gv)[2], const char* kbase, const char* vbase, size_t tstep, int k0, int k1, int kt_hi,
                                             u64 umask, u64 sel, int wq0, int sq, int RB, int W, const LAS float* LUT, int h, int wave) {
#define R32_ISSUE(ktile_, slot_) do { const char* kp_ = kbase + (size_t)(ktile_) * tstep; const char* vp_ = vbase + (size_t)(ktile_) * tstep; \
        LAS unsigned char* sb_ = lds + (slot_) * R32_SLOT + (2 * wave) * 1024; \
        __builtin_amdgcn_global_load_lds((const unsigned*)(kp_ + gk[0]), (LAS unsigned*)(sb_), 16, 0, 0); \
        __builtin_amdgcn_global_load_lds((const unsigned*)(kp_ + gk[1]), (LAS unsigned*)(sb_ + 1024), 16, 0, 0); \
        __builtin_amdgcn_global_load_lds((const unsigned*)(vp_ + gv[0]), (LAS unsigned*)(sb_ + R32_V), 16, 0, 0); \
        __builtin_amdgcn_global_load_lds((const unsigned*)(vp_ + gv[1]), (LAS unsigned*)(sb_ + R32_V + 1024), 16, 0, 0); } while (0)
#define R32_NEXT(k_) do { ++(k_); if (MODE == 1) { while ((k_) <= kt_hi && !((umask >> (k_)) & 1ull)) ++(k_); } } while (0)
    int slot = 0; bool pneed = false, pmb = false; int pslot = 0;
    f32x16 S0, S1;
#pragma unroll
    for (int i = 0; i < 16; ++i) { S0[i] = 0.f; S1[i] = 0.f; }
    while (k0 <= kt_hi) {
        int k2 = k1; if (k1 <= kt_hi) R32_NEXT(k2);
        if (k1 <= kt_hi) asm volatile("s_waitcnt vmcnt(4)" ::: "memory"); else asm volatile("s_waitcnt vmcnt(0)" ::: "memory");
        __builtin_amdgcn_s_barrier();
        __builtin_amdgcn_sched_barrier(0);
        if (k2 <= kt_hi) { const int s2 = slot + 2 >= R32_NSLOT ? slot + 2 - R32_NSLOT : slot + 2; R32_ISSUE(k2, s2); }
        const int key0 = k0 * 64;
        const bool mb = (MODE == 1) ? (((sel >> k0) & 1ull) != 0ull) : true;
        bool need = (wq0 + 31 >= key0);
        if (MODE == 0) need = need && (wq0 - (key0 + 63) <= W);
        if (MODE == 1) need = need && (__ballot(mb) != 0ull);
        const int dmin = wq0 - (key0 + 63), dmax = wq0 + 31 - key0;
        const bool interior = (dmin >= 0) && (MODE == 1 || dmax <= W);
        if (!LAG) { if (need) { flash32_p1<MODE>(O, m, l, S0, S1, qf, lds + slot * R32_SLOT, koff, LUT + (RB - sq + key0 + 4 * h), sq - (key0 + 4 * h), interior, W, mb);
                                flash32_p2<MODE>(O, S0, S1, lds + slot * R32_SLOT, voff, mb); } }
        else { if (pneed) flash32_p2<MODE>(O, S0, S1, lds + pslot * R32_SLOT, voff, pmb);
               if (need) flash32_p1<MODE>(O, m, l, S0, S1, qf, lds + slot * R32_SLOT, koff, LUT + (RB - sq + key0 + 4 * h), sq - (key0 + 4 * h), interior, W, mb);
               pneed = need; pmb = mb; pslot = slot; }
        k0 = k1; k1 = k2; slot = slot + 1 >= R32_NSLOT ? 0 : slot + 1;
    }
    if (LAG) { if (pneed) flash32_p2<MODE>(O, S0, S1, lds + pslot * R32_SLOT, voff, pmb); }
}
__device__ __forceinline__ void build_lut32(Frame& F, int h, int maxd, float m0);
template <int MODE>
__device__ __forceinline__ void flash32(Frame& F, f32x16 (&O)[4], float& m, float& l, const bf16x8 (&qf)[8], const KVSrc kv, int q0, int W, int RB, u64 sel, u64 umask, int lut_h, int lut_maxd, float m0) {
    const int lane = F.lane, wave = F.wave, r = lane & 31, h = lane >> 5;
    const LAS float* LUT = (const LAS float*)(F.lds + LUT32_OFF);
    const int wq0 = q0 + wave * 32, sq = wq0 + r;
    int kt_lo = 0; const int kt_hi = (q0 + 255) >> 6;
    if (MODE == 0) { const int lo = q0 - W; kt_lo = lo > 0 ? (lo >> 6) : 0; }
#pragma unroll
    for (int dt = 0; dt < 4; ++dt) { for (int i = 0; i < 16; ++i) O[dt][i] = 0.f; }
    l = 0.f;
    int koff[8], voff[4];
#pragma unroll
    for (int ds = 0; ds < 8; ++ds) koff[ds] = r * 256 + ((((ds << 1) | h) ^ (r & 15)) << 4);
    { const int i16 = lane & 15, g = lane >> 4, q = i16 >> 2;
#pragma unroll
      for (int dt = 0; dt < 4; ++dt) voff[dt] = (4 * h + q) * 256 + ((dt ^ q) << 6) + (g & 1) * 32 + (i16 & 3) * 8; }
    size_t gk[2], gv[2];
#pragma unroll
    for (int i = 0; i < 2; ++i) { const int row = 4 * (2 * wave + i) + (lane >> 4), cs = lane & 15;
        gk[i] = (size_t)(row * kv.dil) * NP * 2 + (size_t)((cs ^ (row & 15)) << 4); gv[i] = (size_t)(row * kv.dil) * NP * 2 + (size_t)((cs ^ ((row & 3) << 2)) << 4); }
    const char* kbase = (const char*)kv.k + (size_t)kv.res * NP * 2; const char* vbase = (const char*)kv.v + (size_t)kv.res * NP * 2;
    const size_t tstep = (size_t)64 * kv.dil * NP * 2;
    int k0 = kt_lo - 1; R32_NEXT(k0);
    int k1 = k0; if (k0 <= kt_hi) R32_NEXT(k1);
    __syncthreads();
    { LAS unsigned char* lds = F.lds;
      if (k0 <= kt_hi) R32_ISSUE(k0, 0);
      if (k1 <= kt_hi) R32_ISSUE(k1, 1); }
    build_lut32(F, lut_h, lut_maxd, m0);
    if (wave >= 4) flash32_loop<MODE, true>(F.lds, O, m, l, qf, koff, voff, gk, gv, kbase, vbase, tstep, k0, k1, kt_hi, umask, sel, wq0, sq, RB, W, LUT, h, wave);
    else flash32_loop<MODE, false>(F.lds, O, m, l, qf, koff, voff, gk, gv, kbase, vbase, tstep, k0, k1, kt_hi, umask, sel, wq0, sq, RB, W, LUT, h, wave);
#undef R32_ISSUE
#undef R32_NEXT
    __syncthreads();
    l += __shfl_xor(l, 32);
}
__device__ __forceinline__ void build_lut32(Frame& F, int h, int maxd, float m0) {
    const float* bl = WSP(float, WS_BL) + h * 4096; LAS float* LUT = (LAS float*)(F.lds + LUT32_OFF);
    const int RB = maxd + LUT_EXTRA, n = RB + LUT_PAD;
    __syncthreads();
    float v[9];
#pragma unroll
    for (int u = 0; u < 9; ++u) { const int d = RB - (F.tid + u * 512), dc = d < 0 ? 0 : (d > maxd ? maxd : d); v[u] = bl[dc]; }
#pragma unroll
    for (int u = 0; u < 9; ++u) { const int i = F.tid + u * 512, d = RB - i; if (i < n) LUT[i] = (d >= 0 && d <= maxd) ? v[u] * LOG2E - m0 : -m0; }
    __syncthreads();
}
__device__ __forceinline__ void a_item32(Frame& F, int layer, int item) {
    const bf16* P = WSP(bf16, WS_P); bf16* MIX = WSP(bf16, WS_MIX); const u64* SEL = WSP(u64, WS_SEL);
    const int lane = F.lane, r = lane & 31, hh = lane >> 5;
    const int bh6 = item % 24, qt = 15 - item / 24, b = bh6 / 6, h = bh6 % 6, hk = h / 3;
    const int q0 = qt * 256, t = q0 + F.wave * 32 + r; const size_t row = (size_t)b * T + t;
    const u64 sel = SEL[(size_t)(b * 2 + hk) * T + t];
    unsigned ulo = (unsigned)sel, uhi = (unsigned)(sel >> 32);
#pragma unroll
    for (int o = 1; o < 64; o <<= 1) { ulo |= __shfl_xor(ulo, o); uhi |= __shfl_xor(uhi, o); }
    LAS unsigned* UM = (LAS unsigned*)(F.lds + UM32_OFF);
    __syncthreads();
    if (lane == 0) { UM[F.wave * 2] = ulo; UM[F.wave * 2 + 1] = uhi; }
    const float m0s = WSP(float, WS_M0)[layer * 8 + 0], m0w = WSP(float, WS_M0)[layer * 8 + 1];
    __syncthreads();
    unsigned alo = 0u, ahi = 0u;
#pragma unroll
    for (int w = 0; w < 8; ++w) { alo |= UM[w * 2]; ahi |= UM[w * 2 + 1]; }
    const u64 umask = ((u64)ahi << 32) | alo;
    bf16x8 qf[8];
#pragma unroll
    for (int ks = 0; ks < 8; ++ks) qf[ks] = *(const bf16x8*)(P + row * NP + C_QA + h * 128 + ks * 16 + hh * 8);
    const bf16* pb = P + (size_t)b * T * NP;
    {   f32x16 O1[4]; float m1, l1;
        const KVSrc kv{pb + C_KSA + hk * 128, pb + C_VSA + hk * 128, 1, 0}; flash32<1>(F, O1, m1, l1, qf, kv, q0, 0, q0 + 255 + LUT_EXTRA, sel, umask, h, q0 + 255, m0s);
        int l2 = threadIdx.x & 63; asm volatile("" : "+v"(l2));
        const size_t row2 = (size_t)b * T + q0 + F.wave * 32 + (l2 & 31);
        bf16* op = MIX + row2 * DM + h * 128 + 4 * (l2 >> 5);
        const float g1 = sigmoidf_(bf2f(P[row2 * NP + C_GA + h * 3 + 1])) / l1;
#pragma unroll
        for (int dt = 0; dt < 4; ++dt)
#pragma unroll
            for (int gq = 0; gq < 4; ++gq) { bf16* p = op + dt * 32 + 8 * gq; const v2u c = *(const v2u*)p;
                v2u w; w.x = pk2(bflo(c.x) + g1 * O1[dt][4 * gq], bfhi(c.x) + g1 * O1[dt][4 * gq + 1]); w.y = pk2(bflo(c.y) + g1 * O1[dt][4 * gq + 2], bfhi(c.y) + g1 * O1[dt][4 * gq + 3]); *(v2u*)p = w; }
    }
    {   f32x16 O2[4]; float m2, l2;
        const KVSrc kv{pb + C_KWA + hk * 128, pb + C_VWA + hk * 128, 1, 0}; flash32<0>(F, O2, m2, l2, qf, kv, q0, 511, 511 + LUT_EXTRA, 0ull, 0ull, h, 511, m0w);
        int l3 = threadIdx.x & 63; asm volatile("" : "+v"(l3));
        const size_t row2 = (size_t)b * T + q0 + F.wave * 32 + (l3 & 31);
        bf16* op = MIX + row2 * DM + h * 128 + 4 * (l3 >> 5);
        const float g2 = sigmoidf_(bf2f(P[row2 * NP + C_GA + h * 3 + 2])) / l2;
#pragma unroll
        for (int dt = 0; dt < 4; ++dt)
#pragma unroll
            for (int gq = 0; gq < 4; ++gq) { bf16* p = op + dt * 32 + 8 * gq; const v2u c = *(const v2u*)p;
                v2u w; w.x = pk2(bflo(c.x) + g2 * O2[dt][4 * gq], bfhi(c.x) + g2 * O2[dt][4 * gq + 1]); w.y = pk2(bflo(c.y) + g2 * O2[dt][4 * gq + 2], bfhi(c.y) + g2 * O2[dt][4 * gq + 3]); *(v2u*)p = w; }
    }
}
__device__ __forceinline__ void ccombine_phase(Frame& F) {
    bf16* MIX = WSP(bf16, WS_MIX); const float* LSE = WSP(float, WS_LSE);
    const int gw = F.bid * NWAVES + F.wave, NGW = F.G * NWAVES, sub = F.lane & 15, quad = F.lane >> 4;
    const int total = M * 6 / 4;
    constexpr int U = 4;
    for (int base = gw; base < total; base += NGW * U) {
        v4u w[U]; bf16* pp[U]; float al[U]; bool ok[U];
#pragma unroll
        for (int u = 0; u < U; ++u) {
            const int wi = base + u * NGW; ok[u] = wi < total;
            const int gi = (ok[u] ? wi : gw) * 4 + quad, mrow = gi / 6, hq = gi - mrow * 6, j = hq & 1;
            const float* ls = LSE + (size_t)mrow * 6;
            const float a0 = ls[j], a1 = ls[2 + j], a2 = ls[4 + j], mine = ls[hq];
            const float mx = fmaxf(a0, fmaxf(a1, a2));
            al[u] = __expf(mine - mx) / (__expf(a0 - mx) + __expf(a1 - mx) + __expf(a2 - mx));
            pp[u] = MIX + (size_t)mrow * DM + (10 + hq) * 128 + sub * 8;
            w[u] = *(const v4u*)pp[u];
        }
#pragma unroll
        for (int u = 0; u < U; ++u) { const float alpha = al[u];
            v4u o; o.x = pk2(bflo(w[u].x) * alpha, bfhi(w[u].x) * alpha); o.y = pk2(bflo(w[u].y) * alpha, bfhi(w[u].y) * alpha);
            o.z = pk2(bflo(w[u].z) * alpha, bfhi(w[u].z) * alpha); o.w = pk2(bflo(w[u].w) * alpha, bfhi(w[u].w) * alpha);
            if (ok[u]) *(v4u*)pp[u] = o; }
    }
}

#define XB_TMO      128
#define XB_XCNT(j)  (256  + 64 * (j))
#define XB_XSUB(j)  (1280 + 64 * (j))
#define XB_XGEN(j)  (2304 + 64 * (j))
#define XB_TOP      3328
#define XB_TOPGEN   3392
#define XCD_BAR_WORDS 3456
#define XB_SPIN_CAP (1u << 22)

__device__ __forceinline__ unsigned xb_ld(unsigned* p)              { return __hip_atomic_load(p, __ATOMIC_RELAXED, __HIP_MEMORY_SCOPE_AGENT); }
__device__ __forceinline__ unsigned xb_add(unsigned* p, unsigned v) { return __hip_atomic_fetch_add(p, v, __ATOMIC_RELAXED, __HIP_MEMORY_SCOPE_AGENT); }
__device__ __forceinline__ unsigned xb_xcc_id() { return (unsigned)__builtin_amdgcn_s_getreg((3 << 11) | 20) & 0xFu; }
#define XB_SPIN(cond, bar) do { unsigned _sp = 0; while (cond) { __builtin_amdgcn_s_sleep(1); \
    if ((++_sp & 255u) == 0u) { if (xb_ld(&(bar)[XB_TMO])) break; if (_sp > XB_SPIN_CAP) { atomicAdd(&(bar)[XB_TMO], 1u); break; } } } } while (0)

struct XcdBarrier {
    unsigned* bar; unsigned x;
    volatile LAS unsigned* st;
};

__device__ __forceinline__ XcdBarrier xcd_barrier_post(unsigned* bar, volatile LAS unsigned* st) {
    XcdBarrier b; b.bar = bar; b.x = xb_xcc_id(); b.st = st;
    if (threadIdx.x == 0) (void)xb_add(&bar[XB_XCNT(b.x)], 1u);
    return b;
}
__device__ __forceinline__ void xcd_barrier_complete(unsigned* bar, unsigned x, unsigned& nloc, unsigned& nx) {
    const unsigned G = gridDim.x * gridDim.y * gridDim.z;
    unsigned sum, cnt, mine, sp = 0u;
    for (;;) {
        sum = 0u; cnt = 0u; mine = 0u;
#pragma unroll
        for (unsigned j = 0; j < 16; ++j) { const unsigned c = xb_ld(&bar[XB_XCNT(j)]); sum += c; cnt += (c > 0u) ? 1u : 0u; mine = (j == x) ? c : mine; }
        if (sum == G) break;
        __builtin_amdgcn_s_sleep(1);
        if ((++sp & 255u) == 0u) { if (xb_ld(&bar[XB_TMO])) break; if (sp > XB_SPIN_CAP) { atomicAdd(&bar[XB_TMO], 1u); break; } }
    }
    nloc = mine > 0u ? mine : 1u; nx = cnt > 0u ? cnt : 1u;
}

__device__ __forceinline__ void xcd_barrier(const XcdBarrier& b) {
    asm volatile("s_waitcnt vmcnt(0)" ::: "memory");
    __syncthreads();
    if (threadIdx.x == 0) {
        unsigned* bar = b.bar;
        __builtin_amdgcn_s_waitcnt(0);
        unsigned nloc = b.st[0], nx = b.st[1];
        if (nloc == 0u) { xcd_barrier_complete(bar, b.x, nloc, nx); b.st[0] = nloc; b.st[1] = nx; }
        const unsigned old = xb_add(&bar[XB_XSUB(b.x)], 1u);
        const unsigned gen = old / nloc;
        if (old + 1u == (gen + 1u) * nloc) {
            __builtin_amdgcn_fence(__ATOMIC_RELEASE, "agent");
            asm volatile("s_waitcnt vmcnt(0)" ::: "memory");
            const unsigned og = xb_add(&bar[XB_TOP], 1u);
            const unsigned tg = og / nx;
            if (og + 1u == (tg + 1u) * nx) xb_add(&bar[XB_TOPGEN], 1u);
            else XB_SPIN(xb_ld(&bar[XB_TOPGEN]) == tg, bar);
            __builtin_amdgcn_fence(__ATOMIC_ACQUIRE, "agent");
            xb_add(&bar[XB_XGEN(b.x)], 1u);
            asm volatile("s_waitcnt vmcnt(0)" ::: "memory");
        } else {
            XB_SPIN(xb_ld(&bar[XB_XGEN(b.x)]) == gen, bar);
            __builtin_amdgcn_fence(__ATOMIC_ACQUIRE, "agent");
            asm volatile("s_waitcnt vmcnt(0)" ::: "memory");
        }
    }
    __syncthreads();
}

constexpr int N_PHASES = 19;
template <unsigned PM>
__global__ void __launch_bounds__(512, 2) fwd_kernel(Args args) {
    extern __shared__ __attribute__((aligned(16))) unsigned char lds_raw[];
    Frame F;
    F.lds = (LAS unsigned char*)lds_raw; F.tid = threadIdx.x; F.lane = F.tid & 63; F.wave = __builtin_amdgcn_readfirstlane(F.tid >> 6);
    F.G = gridDim.x; F.bid = blockIdx.x; F.a = &args; F.ws = args.ws;
    const int lo = args.ph_lo, hi = args.ph_hi;
    volatile LAS unsigned* bar_st = (volatile LAS unsigned*)(F.lds + LDS_BYTES - 64);
    if (F.tid < 16) bar_st[F.tid] = 0u;
    __syncthreads();
    XcdBarrier xbar; xbar.bar = (unsigned*)(F.ws + WS_CTL); xbar.x = 0; xbar.st = bar_st;
    if (hi - lo > 2) xbar = xcd_barrier_post((unsigned*)(F.ws + WS_CTL), bar_st);
#define IN(k) (lo <= (k) && (k) < hi)
#define HAS(bit) ((PM >> (bit)) & 1u)
#define OPAQUE_TID() do { int t_ = threadIdx.x; asm volatile("" : "+v"(t_)); F.tid = t_; F.lane = t_ & 63; int b_ = blockIdx.x; asm volatile("" : "+s"(b_)); F.bid = b_; } while (0)
#define SEAM(k) do { if (IN(k) && IN((k) + 1)) { if (lo < 0) cg::this_grid().sync(); else xcd_barrier(xbar); } } while (0)
    if constexpr (HAS(0)) { if (IN(0)) { for (int rep = 0; rep < PR_MISC; ++rep) { OPAQUE_TID(); prologue_phase(F); } } }
#pragma unroll 1
    for (int layer = 0; layer < 2; ++layer) {
        const int pb = 1 + 9 * layer;
        unsigned char* wl = F.ws + WS_W + (size_t)layer * W_LAYER;
        const float* xin = layer == 0 ? args.x : args.out;
        if constexpr (HAS(1)) if (IN(pb + 0)) { OPAQUE_TID(); rms_phase(F, xin, args.norm_attn + layer * DM, WSP(bf16, WS_H)); }
        SEAM(pb + 0);
        if constexpr (HAS(2)) if (IN(pb + 1)) { OPAQUE_TID(); pg8::Gemm g{WSP(bf16, WS_H), (const bf16*)(wl + W_IN), M, NP, DM}; pg8::StaticOrder S; S.init(M, NP, F.G, F.bid);
            EpiStoreBf16 E{WSP(bf16, WS_P), NP, args.qk_gain + (size_t)layer * 8 * 128, (LAS float*)(F.lds + 131072)}; for (int rep = 0; rep < PR_GEMM; ++rep) pg8::gemm_phase<EpiStoreBf16, pg8::StaticOrder, true, true>(F.lds, g, S, E); }
        SEAM(pb + 1);
        if constexpr (HAS(3)) if (IN(pb + 2)) { OPAQUE_TID(); for (int it = F.bid; it < 256; it += F.G) { OPAQUE_TID(); compress_item(F, layer, it); }
            for (int it = F.bid; it < 512 + 768; it += F.G) { OPAQUE_TID(); if (it < 512) b_item(F, layer, it); else c_item(F, layer, it - 512); } }
        SEAM(pb + 2);
        if constexpr (HAS(4)) if (IN(pb + 3)) { OPAQUE_TID(); for (int it = F.bid; it < 256; it += F.G) { OPAQUE_TID(); cmp_item(F, layer, (it & 7) * 32 + (it >> 3)); } }
        SEAM(pb + 3);
        if constexpr (HAS(5)) if (IN(pb + 4)) { OPAQUE_TID();
            if (F.G == 256) {
                const int xs = F.bid & 7, j = F.bid >> 3, base = (xs >> 1) * 6 + (xs & 1) * 3;
                a_item32(F, layer, (j / 3) * 24 + base + j % 3); OPAQUE_TID();
                if (j >= 16) { const int k2 = 63 - j; a_item32(F, layer, (k2 / 3) * 24 + base + k2 % 3); OPAQUE_TID(); } }
            else { for (int it = F.bid; it < 384; it += F.G) { OPAQUE_TID(); a_item32(F, layer, it); } OPAQUE_TID(); }
            ccombine_phase(F); }
        SEAM(pb + 4);
        if constexpr (HAS(6)) if (IN(pb + 5)) { OPAQUE_TID(); pg8::Gemm g{WSP(bf16, WS_MIX), (const bf16*)(wl + W_OUT), M, DM, DM}; pg8::StaticOrder S; S.init(M, DM, F.G, F.bid);
            EpiResidF32 E{xin, args.out, DM}; pg8::gemm_phase<EpiResidF32, pg8::StaticOrder, true, true>(F.lds, g, S, E); }
        SEAM(pb + 5);
        if constexpr (HAS(7)) if (IN(pb + 6)) { OPAQUE_TID(); rms_phase(F, args.out, args.norm_ffn + layer * DM, WSP(bf16, WS_H)); }
        SEAM(pb + 6);
        if constexpr (HAS(8)) if (IN(pb + 7)) { OPAQUE_TID(); pg8::Gemm g{WSP(bf16, WS_H), (const bf16*)(wl + W_GU), M, 2 * FF, DM}; pg8::StaticOrder S; S.init(M, 2 * FF, F.G, F.bid);
            EpiSwiGLU E{WSP(bf16, WS_P), FF}; for (int rep = 0; rep < PR_GEMM; ++rep) pg8::gemm_phase<EpiSwiGLU, pg8::StaticOrder, true, true>(F.lds, g, S, E); }
        SEAM(pb + 7);
        if constexpr (HAS(9)) if (IN(pb + 8)) { OPAQUE_TID(); pg8::Gemm g{WSP(bf16, WS_P), (const bf16*)(wl + W_D), M, DM, FF}; pg8::StaticOrder S; S.init(M, DM, F.G, F.bid);
            EpiResidF32 E{args.out, args.out, DM}; pg8::gemm_phase<EpiResidF32, pg8::StaticOrder, true, true>(F.lds, g, S, E); }
        SEAM(pb + 8);
    }
#undef IN
#undef SEAM
}

extern "C" void kernel_launch(void* const* d_in, const int* in_sizes, int n_in, void* d_out, int out_size, void* d_ws, size_t ws_size, hipStream_t stream) {
    static int grid = 0;
    if (grid == 0) {
        if (n_in != 14 || ws_size < WS_END) { fprintf(stderr, "kernel_launch: unexpected n_in %d / ws_size %zu (need %zu)\n", n_in, ws_size, (size_t)WS_END); grid = -1; return; }
        int dev = 0, cus = 0, per_cu = 0;
        (void)hipGetDevice(&dev); (void)hipDeviceGetAttribute(&cus, hipDeviceAttributeMultiprocessorCount, dev);
#if MK_ONE_LAUNCH
        if (hipFuncSetAttribute((const void*)fwd_kernel<0x3ffu>, hipFuncAttributeMaxDynamicSharedMemorySize, LDS_BYTES) != hipSuccess) { fprintf(stderr, "kernel_launch: hipFuncSetAttribute failed\n"); grid = -1; return; }
        (void)hipOccupancyMaxActiveBlocksPerMultiprocessor(&per_cu, (const void*)fwd_kernel<0x3ffu>, 512, LDS_BYTES);
#else
#define SETATTR_K(kk) if (hipFuncSetAttribute((const void*)fwd_kernel<(1u << kk)>, hipFuncAttributeMaxDynamicSharedMemorySize, LDS_BYTES) != hipSuccess) { fprintf(stderr, "kernel_launch: hipFuncSetAttribute failed\n"); grid = -1; return; }
        SETATTR_K(0) SETATTR_K(1) SETATTR_K(2) SETATTR_K(3) SETATTR_K(4) SETATTR_K(5) SETATTR_K(6) SETATTR_K(7) SETATTR_K(8) SETATTR_K(9)
#undef SETATTR_K
        per_cu = 1;
#endif
        (void)hipGetLastError();
        if (per_cu < 1) per_cu = 1;
        grid = cus * per_cu;
    }
    if (grid < 0) return;
    Args a{};
    a.x = (const float*)d_in[0]; a.norm_attn = (const float*)d_in[1]; a.w_in = (const float*)d_in[2]; a.qk_gain = (const float*)d_in[3];
    a.cmp_pe = (const float*)d_in[4]; a.cmp_w1 = (const float*)d_in[5]; a.cmp_w2 = (const float*)d_in[6]; a.sinks = (const float*)d_in[7];
    a.rel_bias = (const float*)d_in[8]; a.w_out = (const float*)d_in[9]; a.norm_ffn = (const float*)d_in[10]; a.w_gate = (const float*)d_in[11];
    a.w_up = (const float*)d_in[12]; a.w_down = (const float*)d_in[13]; a.out = (float*)d_out; a.ws = (unsigned char*)d_ws;
#if MK_ONE_LAUNCH
    if (hipMemsetAsync((char*)d_ws + WS_CTL, 0, CTL_BYTES, stream) != hipSuccess) { fprintf(stderr, "kernel_launch: memset of the barrier words failed\n"); return; }
    a.ph_lo = 0; a.ph_hi = N_PHASES;
    void* kargs[] = {&a};
    hipError_t e = hipLaunchCooperativeKernel((const void*)fwd_kernel<0x3ffu>, dim3(grid), dim3(512), kargs, LDS_BYTES, stream);
    if (e != hipSuccess) fprintf(stderr, "cooperative launch failed: %s (grid %d)\n", hipGetErrorString(e), grid);
#else
    for (int p = 0; p < N_PHASES; ++p) {
        a.ph_lo = p; a.ph_hi = p + 1;
        const int k = p == 0 ? 0 : 1 + (p - 1) % 9;
        switch (k) {
#define LAUNCH_K(kk) case kk: hipLaunchKernelGGL(fwd_kernel<(1u << kk)>, dim3(grid), dim3(512), LDS_BYTES, stream, a); break;
            LAUNCH_K(0) LAUNCH_K(1) LAUNCH_K(2) LAUNCH_K(3) LAUNCH_K(4) LAUNCH_K(5) LAUNCH_K(6) LAUNCH_K(7) LAUNCH_K(8) LAUNCH_K(9)
#undef LAUNCH_K
        }
    }
#endif
}
```

```cpp
#include <hip/hip_runtime.h>
#include <hip/hip_cooperative_groups.h>
#include <cstdio>
#include <cstdint>
namespace cg = cooperative_groups;

#ifndef PR_GEMM
#define PR_GEMM 1
#endif
#ifndef PR_ATT1
#define PR_ATT1 1
#endif
#ifndef PR_ATT2
#define PR_ATT2 1
#endif
#ifndef PR_MISC
#define PR_MISC 1
#endif
#ifndef MK_ONE_LAUNCH
#define MK_ONE_LAUNCH 1
#endif

namespace pg8 {
#define PG8_LAS __attribute__((address_space(3)))
typedef unsigned short bf16_t;
typedef short bf16x8 __attribute__((ext_vector_type(8)));
typedef float f32x4 __attribute__((ext_vector_type(4)));
typedef unsigned u32x4 __attribute__((ext_vector_type(4)));
constexpr int BM = 256, BK = 64, HALF = 128, HTB = HALF * BK * 2  , STAGE_BYTES = 8 * HTB, NXCD = 8, WGM = 8;

__host__ __device__ __forceinline__ int lds_byte(int r, int c) { const int st = (r >> 4) * 2 + (c >> 5), rr = r & 15, cc = c & 31, ob = rr * 64 + cc * 2; return st * 1024 + (ob ^ (((ob >> 9) & 1) << 5)); }
__host__ __device__ __forceinline__ void stage_rc(int b, int& R, int& C) { const int st = b / 1024, sb = b % 1024, swz = sb ^ (((sb >> 9) & 1) << 5); R = (st >> 1) * 16 + swz / 64; C = (st & 1) * 32 + (swz % 64) / 2; }
__host__ __device__ __forceinline__ int perm32(int rho) { const int n = rho >> 4, i = rho & 15; return 8 * (i >> 2) + 4 * n + (i & 3); }

struct Unit { int pm, pn; };
struct Gemm { const bf16_t* A; const bf16_t* Bt; int M, N, K; };

struct StaticOrder {
    int nM, nN, nwg, G, c;
    __host__ __device__ void init(int M, int N, int G_, int c_) { nM = M / BM; nN = N / BM; nwg = nM * nN; G = G_; c = c_; }
    __host__ __device__ bool next(int i, Unit& u) const {
        const long L = (long)i * G + c; if (L >= nwg) return false;
        int wgid = (int)L; { const int q = nwg / NXCD, r = nwg % NXCD, xcd = wgid % NXCD, off = wgid / NXCD; wgid = (xcd < r ? xcd * (q + 1) : r * (q + 1) + (xcd - r) * q) + off; }
        const int nig = WGM * nN, gid = wgid / nig, fm = gid * WGM, gsz = (nM - fm) < WGM ? (nM - fm) : WGM;
        u.pm = fm + ((wgid % nig) % gsz); u.pn = (wgid % nig) / gsz; return true;
    }
    __device__ __forceinline__ void a_ready(const Unit&) const {}
    __device__ __forceinline__ void done(const Unit&) const {}
};

__device__ __forceinline__ unsigned cvt_pk_bf16(float lo, float hi) { unsigned r; asm volatile("v_cvt_pk_bf16_f32 %0, %1, %2" : "=v"(r) : "v"(lo), "v"(hi)); return r; }
template <class Epi, class Sched, bool ALIGN_EPI = false, bool SP2 = false>
__device__ __forceinline__ void gemm_phase(PG8_LAS unsigned char* lds, const Gemm g, const Sched& S, const Epi& E) {
    int tid_ = threadIdx.x; asm volatile("" : "+v"(tid_));
    const int tid = tid_, wid = __builtin_amdgcn_readfirstlane(tid >> 6), lane = tid & 63, wr = wid >> 2, wc = wid & 3, fr = lane & 15, fq = lane >> 4;
    const int K = g.K, nt = K / BK;
    unsigned voffA[2], voffB[2];
#pragma unroll
    for (int i = 0; i < 2; ++i) { int R, C; stage_rc(tid * 16 + i * 8192, R, C); const int Rb = Epi::PERM ? ((R & ~31) + perm32(R & 31)) : R;
        voffA[i] = (unsigned)(R * K + C) * 2u; voffB[i] = (unsigned)(Rb * K + C) * 2u; }
    const size_t kstep = (size_t)(BK * 2);
    const size_t hstep = (size_t)HALF * K * 2;
    const size_t tstep = 2 * hstep;
    const unsigned ldsw = (unsigned)wid * 1024u;
    const int aoff = lds_byte(wr * 64 + fr, fq * 8), boff = lds_byte(wc * 32 + fr, fq * 8);
#define PG8_SA(b, h) (((b) * 2 + (h)) * HTB)
#define PG8_SB(b, h) ((4 + (b) * 2 + (h)) * HTB)
#define PG8_STAGE(bufoff, gbase, voff) do { _Pragma("unroll") for (int _i = 0; _i < 2; ++_i) \
        __builtin_amdgcn_global_load_lds((const unsigned*)((const char*)(gbase) + (voff)[_i]), (PG8_LAS unsigned*)(lds + (bufoff) + ldsw + _i * 8192), 16, 0, 0); } while (0)
#define PG8_LDA(dst, b, h) do { _Pragma("unroll") for (int m = 0; m < 4; ++m) _Pragma("unroll") for (int k = 0; k < 2; ++k) dst[m][k] = *(const PG8_LAS bf16x8*)(lds + PG8_SA(b, h) + aoff + m * 2048 + k * 1024); } while (0)
#define PG8_LDB(dst, b, h) do { _Pragma("unroll") for (int n = 0; n < 2; ++n) _Pragma("unroll") for (int k = 0; k < 2; ++k) dst[n][k] = *(const PG8_LAS bf16x8*)(lds + PG8_SB(b, h) + boff + n * 2048 + k * 1024); } while (0)
#define PG8_MMA(ai, bj, At, Bt) do { __builtin_amdgcn_s_setprio(1); _Pragma("unroll") for (int m = 0; m < 4; ++m) _Pragma("unroll") for (int n = 0; n < 2; ++n) _Pragma("unroll") for (int k = 0; k < 2; ++k) \
        acc[ai][bj][m][n] = __builtin_amdgcn_mfma_f32_16x16x32_bf16(Bt[n][k], At[m][k], acc[ai][bj][m][n], 0, 0, 0); __builtin_amdgcn_s_setprio(0); } while (0)
#define PG8_WAIT_V(n) asm volatile("s_waitcnt vmcnt(" #n ")" ::: "memory")
#define PG8_WAIT_L(n) asm volatile("s_waitcnt lgkmcnt(" #n ")" ::: "memory")
#define PG8_BAR __builtin_amdgcn_s_barrier()
#define PG8_SCHED __builtin_amdgcn_sched_barrier(0)
    Unit cur, nxt; int ui = 0;
    if (!S.next(0, cur)) return;
    f32x4 acc[2][2][4][2];
#pragma unroll
    for (int a = 0; a < 2; ++a)
#pragma unroll
        for (int b = 0; b < 2; ++b)
#pragma unroll
            for (int m = 0; m < 4; ++m)
#pragma unroll
                for (int n = 0; n < 2; ++n) acc[a][b][m][n] = (f32x4){0.f, 0.f, 0.f, 0.f};
    bf16x8 At[4][2], B0[2][2], B1[2][2];
    const char* cA = (const char*)g.A + (size_t)cur.pm * tstep; const char* cB = (const char*)g.Bt + (size_t)cur.pn * tstep;
    S.a_ready(cur);
    if constexpr (SP2) {
        PG8_STAGE(PG8_SB(0, 0), cB, voffB); PG8_STAGE(PG8_SB(0, 1), cB + hstep, voffB); PG8_STAGE(PG8_SA(0, 0), cA, voffA); PG8_STAGE(PG8_SA(0, 1), cA + hstep, voffA);
        if (wr == 1) PG8_BAR;
        PG8_WAIT_V(2); PG8_BAR;
        PG8_STAGE(PG8_SB(1, 0), cB + kstep, voffB); PG8_STAGE(PG8_SA(1, 0), cA + kstep, voffA); PG8_STAGE(PG8_SB(1, 1), cB + hstep + kstep, voffB);
        PG8_WAIT_V(6); PG8_BAR;
    } else {
        PG8_STAGE(PG8_SB(0, 0), cB, voffB); PG8_STAGE(PG8_SA(0, 0), cA, voffA); PG8_STAGE(PG8_SB(0, 1), cB + hstep, voffB); PG8_STAGE(PG8_SA(0, 1), cA + hstep, voffA);
        if (wr == 1) PG8_BAR;
        PG8_WAIT_V(4); PG8_BAR;
        PG8_STAGE(PG8_SB(1, 0), cB + kstep, voffB); PG8_STAGE(PG8_SA(1, 0), cA + kstep, voffA); PG8_STAGE(PG8_SB(1, 1), cB + hstep + kstep, voffB);
        PG8_WAIT_V(6); PG8_BAR;
    }
    for (;;) {
        const bool has_next = S.next(ui + 1, nxt);
        const char* nA = has_next ? (const char*)g.A + (size_t)nxt.pm * tstep : cA; const char* nB = has_next ? (const char*)g.Bt + (size_t)nxt.pn * tstep : cB;
        for (int t = 0; t < nt; t += 2) {
            const bool last = (t == nt - 2);
            const char* a1 = cA + (size_t)(t + 1) * kstep;
            const char* a2 = last ? nA : cA + (size_t)(t + 2) * kstep; const char* b2 = last ? nB : cB + (size_t)(t + 2) * kstep;
            const char* a3 = a2 + kstep; const char* b3 = b2 + kstep;
            if (last && has_next) S.a_ready(nxt);
            if constexpr (SP2) {
            PG8_LDB(B0, 0, 0); PG8_LDB(B1, 0, 1); PG8_SCHED; PG8_LDA(At, 0, 0); PG8_STAGE(PG8_SA(1, 1), a1 + hstep, voffA);
            PG8_WAIT_V(8); PG8_WAIT_L(0); PG8_BAR; PG8_MMA(0, 0, At, B0); PG8_MMA(0, 1, At, B1); PG8_BAR; PG8_SCHED;
            PG8_LDA(At, 0, 1); PG8_STAGE(PG8_SB(0, 0), b2, voffB); PG8_STAGE(PG8_SB(0, 1), b2 + hstep, voffB); PG8_STAGE(PG8_SA(0, 0), a2, voffA);
            PG8_WAIT_V(8); PG8_WAIT_L(0); PG8_BAR; PG8_MMA(1, 0, At, B0); PG8_MMA(1, 1, At, B1); PG8_BAR; PG8_SCHED;
            PG8_LDB(B0, 1, 0); PG8_LDB(B1, 1, 1); PG8_SCHED; PG8_LDA(At, 1, 0); PG8_STAGE(PG8_SA(0, 1), a2 + hstep, voffA);
            PG8_WAIT_V(8); PG8_WAIT_L(0); PG8_BAR; PG8_MMA(0, 0, At, B0); PG8_MMA(0, 1, At, B1); PG8_BAR; PG8_SCHED;
            PG8_LDA(At, 1, 1); PG8_STAGE(PG8_SB(1, 0), b3, voffB); PG8_STAGE(PG8_SB(1, 1), b3 + hstep, voffB); PG8_STAGE(PG8_SA(1, 0), a3, voffA);
            PG8_WAIT_V(8); PG8_WAIT_L(0); PG8_BAR; PG8_MMA(1, 0, At, B0); PG8_MMA(1, 1, At, B1); PG8_BAR; PG8_SCHED;
            } else {
            PG8_LDB(B0, 0, 0); PG8_SCHED; PG8_LDA(At, 0, 0); PG8_STAGE(PG8_SA(1, 1), a1 + hstep, voffA);
            PG8_WAIT_L(8); PG8_BAR; PG8_WAIT_L(0); PG8_MMA(0, 0, At, B0); PG8_BAR; PG8_SCHED;
            PG8_LDB(B1, 0, 1); PG8_STAGE(PG8_SB(0, 0), b2, voffB);
            PG8_BAR; PG8_WAIT_L(0); PG8_MMA(0, 1, At, B1); PG8_BAR;
            PG8_LDA(At, 0, 1); PG8_STAGE(PG8_SA(0, 0), a2, voffA);
            PG8_BAR; PG8_WAIT_L(0); PG8_MMA(1, 0, At, B0); PG8_BAR; PG8_SCHED;
            PG8_STAGE(PG8_SB(0, 1), b2 + hstep, voffB);
            PG8_WAIT_V(6); PG8_BAR; PG8_MMA(1, 1, At, B1); PG8_BAR;
            PG8_LDB(B0, 1, 0); PG8_SCHED; PG8_LDA(At, 1, 0); PG8_STAGE(PG8_SA(0, 1), a2 + hstep, voffA);
            PG8_WAIT_L(8); PG8_BAR; PG8_WAIT_L(0); PG8_MMA(0, 0, At, B0); PG8_BAR; PG8_SCHED;
            PG8_LDB(B1, 1, 1); PG8_STAGE(PG8_SB(1, 0), b3, voffB);
            PG8_BAR; PG8_WAIT_L(0); PG8_MMA(0, 1, At, B1); PG8_BAR;
            PG8_LDA(At, 1, 1); PG8_STAGE(PG8_SA(1, 0), a3, voffA);
            PG8_BAR; PG8_WAIT_L(0); PG8_MMA(1, 0, At, B0); PG8_BAR; PG8_SCHED;
            PG8_STAGE(PG8_SB(1, 1), b3 + hstep, voffB);
            PG8_WAIT_V(6); PG8_BAR; PG8_MMA(1, 1, At, B1); PG8_BAR;
            }
        }
        if constexpr (ALIGN_EPI) { if (wr == 0) PG8_BAR; }
        if constexpr (!Epi::AFTER_DRAIN) { E(acc, cur, wr, wc, fr, fq); S.done(cur); }
        if (!has_next) break;
#pragma unroll
        for (int a = 0; a < 2; ++a)
#pragma unroll
            for (int b = 0; b < 2; ++b)
#pragma unroll
                for (int m = 0; m < 4; ++m)
#pragma unroll
                    for (int n = 0; n < 2; ++n) acc[a][b][m][n] = (f32x4){0.f, 0.f, 0.f, 0.f};
        cur = nxt; cA = nA; cB = nB; ++ui;
        if constexpr (ALIGN_EPI) { if (wr == 1) PG8_BAR; }
    }
    PG8_WAIT_V(0);
    if constexpr (!ALIGN_EPI) { if (wr == 0) PG8_BAR; }
    PG8_BAR;
    if constexpr (Epi::AFTER_DRAIN) { E.fused(acc, cur, wr, wc, fr, fq, lds, wid, lane); S.done(cur); }
#undef PG8_SA
#undef PG8_SB
#undef PG8_STAGE
#undef PG8_LDA
#undef PG8_LDB
#undef PG8_MMA
#undef PG8_WAIT_V
#undef PG8_WAIT_L
#undef PG8_BAR
#undef PG8_SCHED
}
}

#define LAS __attribute__((address_space(3)))
typedef unsigned short bf16;
typedef unsigned v4u __attribute__((ext_vector_type(4)));
typedef unsigned v2u __attribute__((ext_vector_type(2)));
typedef float f32x4 __attribute__((ext_vector_type(4)));
typedef short bf16x8 __attribute__((ext_vector_type(8)));
typedef short s16x4 __attribute__((ext_vector_type(4)));
typedef float f32x2_t __attribute__((ext_vector_type(2)));
typedef __bf16 bf16x2_t __attribute__((ext_vector_type(2)));
typedef unsigned long long u64;

constexpr int NB = 4, T = 4096, DM = 2048, M = NB * T, NP = 5120, FF = 5632, NIN = 4882, NWAVES = 8;
constexpr float SCALE = 0.08838834764831845f, EPS = 1e-6f;
constexpr int C_QA = 0, C_KCA = 768, C_VCA = 1024, C_KSA = 1280, C_VSA = 1536, C_KWA = 1792, C_VWA = 2048,
              C_QB = 2304, C_KB = 2816, C_VB = 3072, C_QC = 3328, C_KC = 4096, C_VC = 4480, C_GA = 4864;
constexpr size_t MiB = 1u << 20;
constexpr size_t WS_BL = 0, WS_M0 = 512 * 1024, WS_KC = 1 * MiB, WS_VCT = 1 * MiB + 512 * 1024, WS_SEL = 2 * MiB, WS_LSE = 2 * MiB + 512 * 1024;
constexpr size_t WS_CTL = 3 * MiB, CTL_BYTES = 16384;
constexpr size_t WS_W = 4 * MiB, W_LAYER = 97 * MiB, W_IN = 0, W_OUT = 20 * MiB, W_GU = 28 * MiB, W_D = 72 * MiB, W_C1 = 94 * MiB, W_C2 = 96 * MiB;
constexpr size_t WS_H = 198 * MiB, WS_MIX = 262 * MiB, WS_P = 326 * MiB, WS_END = 502 * MiB;
constexpr int LDS_BYTES = 155648;

__device__ __forceinline__ unsigned f2bf(float f) { unsigned u = __builtin_bit_cast(unsigned, f); return (u + 0x7fffu + ((u >> 16) & 1u)) >> 16; }
__device__ __forceinline__ unsigned pk2(float lo, float hi) { f32x2_t v = {lo, hi}; bf16x2_t b = __builtin_convertvector(v, bf16x2_t); return __builtin_bit_cast(unsigned, b); }
__device__ __forceinline__ float bf2f(unsigned short h) { return __builtin_bit_cast(float, (unsigned)h << 16); }
__device__ __forceinline__ float bflo(unsigned u) { return __builtin_bit_cast(float, u << 16); }
__device__ __forceinline__ float bfhi(unsigned u) { return __builtin_bit_cast(float, u & 0xffff0000u); }
__device__ __forceinline__ float wave_sum(float v) {
#pragma unroll
    for (int o = 1; o < 64; o <<= 1) v += __shfl_xor(v, o);
    return v;
}
__device__ __forceinline__ float sigmoidf_(float x) { return 1.f / (1.f + __expf(-x)); }
__device__ __forceinline__ s16x4 vtr(LAS const unsigned char* p) { typedef short v4i16_t __attribute__((ext_vector_type(4))); return __builtin_bit_cast(s16x4, __builtin_amdgcn_ds_read_tr16_b64_v4i16((LAS v4i16_t*)p)); }

struct Args {
    const float *x, *norm_attn, *w_in, *qk_gain, *cmp_pe, *cmp_w1, *cmp_w2, *sinks, *rel_bias, *w_out, *norm_ffn, *w_gate, *w_up, *w_down;
    float* out; unsigned char* ws; int ph_lo, ph_hi;
};

__device__ __forceinline__ int unit_gain(int u) {
    if (u < 6) return 0; if (u >= 10 && u < 12) return 2; if (u >= 14 && u < 16) return 3; if (u >= 18 && u < 22) return 4;
    if (u >= 22 && u < 24) return 5; if (u >= 26 && u < 32) return 6; if (u >= 32 && u < 35) return 7; return -1;
}
struct EpiStoreBf16 {
    static constexpr bool PERM = true, AFTER_DRAIN = false;
    bf16* O; int ldc; const float* gains; LAS float* ssx;
    __device__ __forceinline__ void operator()(const f32x4 (&acc)[2][2][4][2], const pg8::Unit& u, int wr, int wc, int fr, int fq) const {
        const int row0 = u.pm * 256 + wr * 64 + fr, col0 = u.pn * 256 + wc * 32 + 8 * fq;
        const int g0 = unit_gain(u.pn * 2), g1 = unit_gain(u.pn * 2 + 1);
        float rn[2][4][2];
        if (g0 >= 0 || g1 >= 0) {
#pragma unroll
            for (int ai = 0; ai < 2; ++ai)
#pragma unroll
                for (int m = 0; m < 4; ++m)
#pragma unroll
                    for (int bj = 0; bj < 2; ++bj) { const f32x4 v0 = acc[ai][bj][m][0], v1 = acc[ai][bj][m][1];
                        float ss = (v0[0] * v0[0] + v0[1] * v0[1]) + (v0[2] * v0[2] + v0[3] * v0[3]) + (v1[0] * v1[0] + v1[1] * v1[1]) + (v1[2] * v1[2] + v1[3] * v1[3]);
                        ss += __shfl_xor(ss, 16); ss += __shfl_xor(ss, 32);
                        if (fq == 0) ssx[(((((wr * 2 + ai) * 4 + m) * 2 + bj) * 16 + fr) << 2) + wc] = ss; }
            asm volatile("s_waitcnt lgkmcnt(0)" ::: "memory");
            __builtin_amdgcn_s_barrier();
            __builtin_amdgcn_sched_barrier(0);
#pragma unroll
            for (int ai = 0; ai < 2; ++ai)
#pragma unroll
                for (int m = 0; m < 4; ++m)
#pragma unroll
                    for (int bj = 0; bj < 2; ++bj) { const f32x4 p = *(const LAS f32x4*)(ssx + (((((wr * 2 + ai) * 4 + m) * 2 + bj) * 16 + fr) << 2));
                        const float tot = (p[0] + p[1]) + (p[2] + p[3]);
                        rn[ai][m][bj] = ((bj ? g1 : g0) >= 0) ? 1.f / sqrtf(tot * (1.f / 128.f) + EPS) : 1.f; }
        }
        f32x4 gv[2][2];
#pragma unroll
        for (int bj = 0; bj < 2; ++bj) { const int gi = bj ? g1 : g0;
            if (gi >= 0) { const float* gp = gains + gi * 128 + wc * 32 + 8 * fq; gv[bj][0] = *(const f32x4*)gp; gv[bj][1] = *(const f32x4*)(gp + 4); }
            else { gv[bj][0] = (f32x4){1.f, 1.f, 1.f, 1.f}; gv[bj][1] = gv[bj][0]; } }
#pragma unroll
        for (int ai = 0; ai < 2; ++ai)
#pragma unroll
            for (int m = 0; m < 4; ++m) { bf16* rowp = O + (size_t)(row0 + ai * 128 + m * 16) * ldc + col0;
#pragma unroll
                for (int bj = 0; bj < 2; ++bj) { const float r = (g0 >= 0 || g1 >= 0) ? rn[ai][m][bj] : 1.f;
                    const f32x4 v0 = acc[ai][bj][m][0] * r * gv[bj][0], v1 = acc[ai][bj][m][1] * r * gv[bj][1];
                    v4u w; w.x = pk2(v0[0], v0[1]); w.y = pk2(v0[2], v0[3]); w.z = pk2(v1[0], v1[1]); w.w = pk2(v1[2], v1[3]);
                    *(v4u*)(rowp + bj * 128) = w; } }
    }
};
struct EpiResidF32 {
    static constexpr bool PERM = true, AFTER_DRAIN = false;
    const float* R; float* O; int ldc;
    __device__ __forceinline__ void operator()(const f32x4 (&acc)[2][2][4][2], const pg8::Unit& u, int wr, int wc, int fr, int fq) const {
        const int row0 = u.pm * 256 + wr * 64 + fr, col0 = u.pn * 256 + wc * 32 + 8 * fq;
#pragma unroll
        for (int ai = 0; ai < 2; ++ai)
#pragma unroll
            for (int m = 0; m < 4; ++m) { const size_t off = (size_t)(row0 + ai * 128 + m * 16) * ldc + col0;
#pragma unroll
                for (int bj = 0; bj < 2; ++bj) {
                    const f32x4 r0 = *(const f32x4*)(R + off + bj * 128), r1 = *(const f32x4*)(R + off + bj * 128 + 4);
                    *(f32x4*)(O + off + bj * 128) = r0 + acc[ai][bj][m][0]; *(f32x4*)(O + off + bj * 128 + 4) = r1 + acc[ai][bj][m][1]; } }
    }
};
struct EpiSwiGLU {
    static constexpr bool PERM = true, AFTER_DRAIN = false;
    bf16* O; int ldc;
    __device__ __forceinline__ void operator()(const f32x4 (&acc)[2][2][4][2], const pg8::Unit& u, int wr, int wc, int fr, int fq) const {
        const int row0 = u.pm * 256 + wr * 64 + fr, col0 = u.pn * 128 + wc * 32 + 8 * fq;
#pragma unroll
        for (int ai = 0; ai < 2; ++ai)
#pragma unroll
            for (int m = 0; m < 4; ++m) { bf16* rowp = O + (size_t)(row0 + ai * 128 + m * 16) * ldc + col0;
                float r[8];
#pragma unroll
                for (int n = 0; n < 2; ++n)
#pragma unroll
                    for (int i = 0; i < 4; ++i) { const float g = acc[ai][0][m][n][i], up = acc[ai][1][m][n][i]; r[n * 4 + i] = g * sigmoidf_(g) * up; }
                v4u w; w.x = pk2(r[0], r[1]); w.y = pk2(r[2], r[3]); w.z = pk2(r[4], r[5]); w.w = pk2(r[6], r[7]);
                *(v4u*)rowp = w; }
    }
};

struct Frame {
    LAS unsigned char* lds;
    int tid, lane, wave, G, bid;
    const Args* a;
    unsigned char* ws;
};
#define WSP(T_, off) ((T_*)(F.ws + (off)))

__device__ __forceinline__ int rel_bucket(int d) {
    if (d < 16) return d;
    int b = 16;
    b += (d >= 22); b += (d >= 30); b += (d >= 40); b += (d >= 54); b += (d >= 73); b += (d >= 99); b += (d >= 134); b += (d >= 182);
    b += (d >= 246); b += (d >= 332); b += (d >= 450); b += (d >= 609); b += (d >= 825); b += (d >= 1117); b += (d >= 1513);
    return b;
}

template <int BLK32 = 0>
__device__ __forceinline__ void tr_item(const float* W, int Nsrc, int K, int k0, int sc, bf16* WTrow0, LAS float* scr, int lane) {
    float v[32];
    const float* wp = W + (size_t)(k0 + (lane >> 5)) * Nsrc + (sc >= 0 ? sc : 0);
#pragma unroll
    for (int i = 0; i < 32; ++i) v[i] = wp[(size_t)(2 * i) * Nsrc];
#pragma unroll
    for (int i = 0; i < 32; ++i) { const int kk = 2 * i + (lane >> 5); scr[kk * 33 + (lane & 31)] = sc >= 0 ? v[i] : 0.f; }
    asm volatile("s_waitcnt lgkmcnt(0)" ::: "memory");
    const int c = lane & 7;
#pragma unroll
    for (int j = 0; j < 4; ++j) { const int n = (lane >> 3) + 8 * j; const LAS float* s = scr + (8 * c) * 33 + n;
        v4u o; o.x = pk2(s[0 * 33], s[1 * 33]); o.y = pk2(s[2 * 33], s[3 * 33]); o.z = pk2(s[4 * 33], s[5 * 33]); o.w = pk2(s[6 * 33], s[7 * 33]);
        if (BLK32) *(v4u*)(WTrow0 + ((size_t)((k0 + 8 * c) >> 5) * 128 + n) * 32 + ((k0 + 8 * c) & 31)) = o;
        else *(v4u*)(WTrow0 + (size_t)n * K + k0 + 8 * c) = o; }
    asm volatile("s_waitcnt lgkmcnt(0)" ::: "memory");
}
__device__ __forceinline__ void prologue_phase(Frame& F) {
    const Args& A = *F.a;
    LAS float* scr = (LAS float*)(F.lds + F.wave * 16384);
    const int gw = F.bid * NWAVES + F.wave, NGW = F.G * NWAVES, lane = F.lane;
    constexpr int I_IN = 32 * 160, I_OUT = 32 * 64, I_GU = 32 * 352, I_D = 88 * 64, I_C1 = 2 * 64 * 4, I_C2 = 2 * 2 * 4;
    constexpr int I_LAYER = I_IN + I_OUT + I_GU + I_D + I_C1 + I_C2;
    for (int it = gw; it < 2 * I_LAYER; it += NGW) {
        const int l = it / I_LAYER; int r = it - l * I_LAYER;
        unsigned char* wl = F.ws + WS_W + (size_t)l * W_LAYER;
        if (r < I_IN) { const int kb = r / 160, nb = r % 160, n = nb * 32 + (lane & 31);
            const int sc = n < 2304 ? n : (n < 4864 ? n + 18 : (n < 4882 ? n - 4864 + 2304 : -1));
            tr_item(A.w_in + (size_t)l * DM * NIN, NIN, DM, kb * 64, sc, (bf16*)(wl + W_IN) + (size_t)nb * 32 * DM, scr, lane); continue; }
        r -= I_IN;
        if (r < I_OUT) { const int kb = r / 64, nb = r % 64;
            tr_item(A.w_out + (size_t)l * DM * DM, DM, DM, kb * 64, nb * 32 + (lane & 31), (bf16*)(wl + W_OUT) + (size_t)nb * 32 * DM, scr, lane); continue; }
        r -= I_OUT;
        if (r < I_GU) { const int kb = r / 352, nb = r % 352, r0 = nb * 32, blk = r0 >> 8, half = (r0 >> 7) & 1, w0 = r0 & 127;
            const float* src = (half ? A.w_up : A.w_gate) + (size_t)l * DM * FF;
            tr_item(src, FF, DM, kb * 64, blk * 128 + w0 + (lane & 31), (bf16*)(wl + W_GU) + (size_t)r0 * DM, scr, lane); continue; }
        r -= I_GU;
        if (r < I_D) { const int kb = r / 64, nb = r % 64;
            tr_item(A.w_down + (size_t)l * FF * DM, DM, FF, kb * 64, nb * 32 + (lane & 31), (bf16*)(wl + W_D) + (size_t)nb * 32 * FF, scr, lane); continue; }
        r -= I_D;
        if (r < I_C1) { const int kv = r / 256, r2 = r % 256, kb = r2 / 4, nb = r2 % 4;
            tr_item<1>(A.cmp_w1 + (size_t)(l * 2 + kv) * 4096 * 128, 128, 4096, kb * 64, nb * 32 + (lane & 31), (bf16*)(wl + W_C1) + (size_t)kv * 128 * 4096 + (size_t)nb * 32 * 32, scr, lane); continue; }
        r -= I_C1;
        { const int kv = r / 8, r2 = r % 8, kb = r2 / 4, nb = r2 % 4;
            tr_item(A.cmp_w2 + (size_t)(l * 2 + kv) * 128 * 128, 128, 128, kb * 64, nb * 32 + (lane & 31), (bf16*)(wl + W_C2) + (size_t)(kv * 128 + nb * 32) * 128, scr, lane); }
    }
    float* BL = WSP(float, WS_BL);
    for (int i = F.bid * 512 + F.tid; i < 16 * 4096; i += F.G * 512) { const int h = i >> 12, d = i & 4095; BL[i] = A.rel_bias[rel_bucket(d) * 16 + h]; }
    if (F.bid == 0 && F.wave == 0) {
        float bm = 0.f;
#pragma unroll
        for (int i = 0; i < 8; ++i) bm = fmaxf(bm, fabsf(A.rel_bias[lane + 64 * i]));
#pragma unroll
        for (int o = 1; o < 64; o <<= 1) bm = fmaxf(bm, __shfl_xor(bm, o));
        for (int l = 0; l < 2; ++l) {
            float g[8];
#pragma unroll
            for (int i = 0; i < 8; ++i) { const float* gp = A.qk_gain + (size_t)(l * 8 + i) * 128; float v = fmaxf(fabsf(gp[lane]), fabsf(gp[lane + 64]));
#pragma unroll
                for (int o = 1; o < 64; o <<= 1) v = fmaxf(v, __shfl_xor(v, o));
                g[i] = v; }
            if (lane == 0) { float* M0 = WSP(float, WS_M0) + l * 8;
                const float c = 128.f * SCALE * 1.4426950408889634f, bb = bm * 1.4426950408889634f + 1.f;
                M0[0] = fminf(c * g[0] * g[2] + bb, 100.f); M0[1] = fminf(c * g[0] * g[3] + bb, 100.f); M0[2] = fminf(c * g[4] * g[5] + bb, 100.f);
                M0[3] = fminf(c * g[6] * g[7] + bb, 100.f); M0[4] = fminf(c * g[0] * g[1] + bb, 100.f); }
        }
    }
}

__device__ __forceinline__ void rms_phase(Frame& F, const float* x, const float* g, bf16* out) {
    const int gw = F.bid * NWAVES + F.wave, NGW = F.G * NWAVES, lane = F.lane;
    f32x4 gv[8];
#pragma unroll
    for (int j = 0; j < 8; ++j) gv[j] = ((const f32x4*)g)[lane + 64 * j];
    for (int m = gw; m < M; m += NGW) {
        const f32x4* xr = (const f32x4*)(x + (size_t)m * DM) + lane;
        f32x4 v[8]; float ss = 0.f;
#pragma unroll
        for (int j = 0; j < 8; ++j) { v[j] = xr[64 * j]; ss += (v[j].x * v[j].x + v[j].y * v[j].y) + (v[j].z * v[j].z + v[j].w * v[j].w); }
        const float r = 1.f / sqrtf(wave_sum(ss) * (1.f / DM) + EPS);
        v2u* o8 = (v2u*)(out + (size_t)m * DM) + lane;
#pragma unroll
        for (int j = 0; j < 8; ++j) { v2u w; w.x = pk2(v[j].x * r * gv[j].x, v[j].y * r * gv[j].y); w.y = pk2(v[j].z * r * gv[j].z, v[j].w * r * gv[j].w); o8[64 * j] = w; }
    }
}

__device__ __forceinline__ void qknorm_phase(Frame& F, int layer) {
    const Args& A = *F.a; bf16* P = WSP(bf16, WS_P);
    const int gw = F.bid * NWAVES + F.wave, NGW = F.G * NWAVES, lane = F.lane, sub = lane & 15, quad = lane >> 4;
    const int total = M * 25 / 4;
    constexpr int U = 5;
    for (int base = gw; base < total; base += NGW * U) {
        v4u w[U]; bf16* pp[U]; int gsel[U]; bool ok[U];
#pragma unroll
        for (int u = 0; u < U; ++u) {
            const int wi = base + u * NGW; ok[u] = wi < total;
            const int gi = (ok[u] ? wi : gw) * 4 + quad, m = gi / 25, uu = gi - m * 25;
            int unit, gidx;
            if (uu < 6) { unit = uu; gidx = 0; } else if (uu < 8) { unit = 10 + (uu - 6); gidx = 2; } else if (uu < 10) { unit = 14 + (uu - 8); gidx = 3; }
            else if (uu < 14) { unit = 18 + (uu - 10); gidx = 4; } else if (uu < 16) { unit = 22 + (uu - 14); gidx = 5; } else if (uu < 22) { unit = 26 + (uu - 16); gidx = 6; }
            else { unit = 32 + (uu - 22); gidx = 7; }
            pp[u] = P + (size_t)m * NP + unit * 128 + sub * 8; gsel[u] = gidx;
            w[u] = *(const v4u*)pp[u];
        }
#pragma unroll
        for (int u = 0; u < U; ++u) {
            float v[8] = {bflo(w[u].x), bfhi(w[u].x), bflo(w[u].y), bfhi(w[u].y), bflo(w[u].z), bfhi(w[u].z), bflo(w[u].w), bfhi(w[u].w)};
            float ss = 0.f;
#pragma unroll
            for (int i = 0; i < 8; ++i) ss += v[i] * v[i];
            ss += __shfl_xor(ss, 1); ss += __shfl_xor(ss, 2); ss += __shfl_xor(ss, 4); ss += __shfl_xor(ss, 8);
            const float r = 1.f / sqrtf(ss * (1.f / 128.f) + EPS);
            const float* gp = A.qk_gain + (size_t)(layer * 8 + gsel[u]) * 128 + sub * 8;
            const f32x4 g0 = *(const f32x4*)gp, g1 = *(const f32x4*)(gp + 4);
            v4u o; o.x = pk2(v[0] * r * g0.x, v[1] * r * g0.y); o.y = pk2(v[2] * r * g0.z, v[3] * r * g0.w);
            o.z = pk2(v[4] * r * g1.x, v[5] * r * g1.y); o.w = pk2(v[6] * r * g1.z, v[7] * r * g1.w);
            if (ok[u]) *(v4u*)pp[u] = o;
        }
    }
}

__device__ __forceinline__ float gelu_tanh(float x) {
    const float u = 0.7978845608028654f * (x + 0.044715f * x * x * x);
    const float e = __expf(2.f * u);
    const float th = 1.f - 2.f / (e + 1.f);
    return 0.5f * x * (1.f + th);
}

__device__ __forceinline__ void compress_item(Frame& F, int layer, int item) {
    const Args& A = *F.a; const bf16* P = WSP(bf16, WS_P);
    const int lane = F.lane, wave = F.wave, fr = lane & 15, fq = lane >> 4;
    const int kv = item & 1, chunk = (item >> 1) & 15, bh = item >> 5, b = bh >> 1, hk = bh & 1;
    const int col0 = (kv ? C_VCA : C_KCA) + hk * 128;
    int n = chunk * 16 + fr; if (n > 254) n = 254;
    const bf16* arow = P + (size_t)(b * T + 16 * n + 4 * wave) * NP + col0 + fq * 8;
    const float* pe = A.cmp_pe + (size_t)((layer * 2 + kv) * 32 + 4 * wave) * 128 + fq * 8;
    const unsigned char* wl = F.ws + WS_W + (size_t)layer * W_LAYER;
    const bf16* w1 = (const bf16*)(wl + W_C1) + (size_t)kv * 128 * 4096 + (size_t)(16 * wave) * 4096 + fr * 32 + fq * 8;
    const bf16* w2 = (const bf16*)(wl + W_C2) + (size_t)(kv * 128 + wave * 16 + fr) * 128 + fq * 8;
    LAS bf16* H1 = (LAS bf16*)F.lds;
    LAS float* part = (LAS float*)(F.lds + 8192);
    LAS float* red = (LAS float*)(F.lds + 16384);
    __syncthreads();
    f32x4 accp[8];
#pragma unroll
    for (int ct = 0; ct < 8; ++ct) accp[ct] = (f32x4){0.f, 0.f, 0.f, 0.f};
#pragma unroll 2
    for (int s16 = 0; s16 < 16; ++s16) {
        const int lt = s16 >> 2, kk = s16 & 3;
        const v4u w = *(const v4u*)(arow + (size_t)lt * NP + kk * 32);
        const f32x4 p0 = *(const f32x4*)(pe + lt * 128 + kk * 32), p1 = *(const f32x4*)(pe + lt * 128 + kk * 32 + 4);
        v4u a; a.x = pk2(bflo(w.x) + p0.x, bfhi(w.x) + p0.y); a.y = pk2(bflo(w.y) + p0.z, bfhi(w.y) + p0.w);
        a.z = pk2(bflo(w.z) + p1.x, bfhi(w.z) + p1.y); a.w = pk2(bflo(w.w) + p1.z, bfhi(w.w) + p1.w);
        const bf16x8 af = __builtin_bit_cast(bf16x8, a);
#pragma unroll
        for (int ct = 0; ct < 8; ++ct) { const bf16x8 bfr = *(const bf16x8*)(w1 + (size_t)s16 * 4096 + ct * 16 * 32);
            accp[ct] = __builtin_amdgcn_mfma_f32_16x16x32_bf16(af, bfr, accp[ct], 0, 0, 0); }
    }
#pragma unroll
    for (int ct = 0; ct < 8; ++ct)
#pragma unroll
        for (int j = 0; j < 4; ++j) red[(wave * 16 + fq * 4 + j) * 132 + ct * 16 + fr] = accp[ct][j];
    __syncthreads();
    f32x4 acc = {0.f, 0.f, 0.f, 0.f};
#pragma unroll
    for (int w = 0; w < 8; ++w)
#pragma unroll
        for (int j = 0; j < 4; ++j) acc[j] += red[(w * 16 + fq * 4 + j) * 132 + wave * 16 + fr];
#pragma unroll
    for (int j = 0; j < 4; ++j) H1[(fq * 4 + j) * 136 + wave * 16 + fr] = (bf16)f2bf(gelu_tanh(acc[j]));
    __syncthreads();
    f32x4 o = {0.f, 0.f, 0.f, 0.f};
#pragma unroll
    for (int ks = 0; ks < 4; ++ks) {
        const bf16x8 af = *(const LAS bf16x8*)(H1 + fr * 136 + ks * 32 + fq * 8);
        const bf16x8 bfr = *(const bf16x8*)(w2 + ks * 32);
        o = __builtin_amdgcn_mfma_f32_16x16x32_bf16(af, bfr, o, 0, 0, 0);
    }
    const int c = wave * 16 + fr, nbase = chunk * 16 + fq * 4;
    if (kv == 0) {
        float ss[4];
#pragma unroll
        for (int j = 0; j < 4; ++j) { float s = o[j] * o[j]; s += __shfl_xor(s, 1); s += __shfl_xor(s, 2); s += __shfl_xor(s, 4); s += __shfl_xor(s, 8); ss[j] = s; }
        if (fr == 0) {
#pragma unroll
            for (int j = 0; j < 4; ++j) part[wave * 16 + fq * 4 + j] = ss[j]; }
        __syncthreads();
        const float gain = A.qk_gain[(size_t)(layer * 8 + 1) * 128 + c];
        bf16* KC = WSP(bf16, WS_KC);
#pragma unroll
        for (int j = 0; j < 4; ++j) { float tot = 0.f;
#pragma unroll
            for (int w = 0; w < 8; ++w) tot += part[w * 16 + fq * 4 + j];
            const float y = o[j] * (1.f / sqrtf(tot * (1.f / 128.f) + EPS)) * gain;
            KC[(size_t)(bh * 256 + nbase + j) * 128 + c] = (nbase + j < 255) ? (bf16)f2bf(y) : (bf16)0; }
    } else {
        bf16* VCT = WSP(bf16, WS_VCT);
        v2u w; w.x = pk2(o[0], o[1]); w.y = pk2(o[2], (nbase + 3 < 255) ? o[3] : 0.f);
        *(v2u*)(VCT + (size_t)(bh * 128 + c) * 256 + nbase) = w;
    }
}

#define CSB() __builtin_amdgcn_sched_barrier(0)
__device__ __forceinline__ void cmp_loadk2(bf16x8 (&kf)[8], const LAS unsigned char* kcb, int tile0) {
#pragma unroll
    for (int t = 0; t < 2; ++t)
#pragma unroll
        for (int ks = 0; ks < 4; ++ks) kf[t * 4 + ks] = *(const LAS bf16x8*)(kcb + (tile0 + t) * 16 * 272 + ks * 64);
}
__device__ __forceinline__ void cmp_loadv(bf16x8 (&vf)[8], const LAS unsigned char* vcb, int step) {
#pragma unroll
    for (int dt = 0; dt < 8; ++dt) { const v2u lo = *(const LAS v2u*)(vcb + dt * 16 * 528 + 64 * step), hi = *(const LAS v2u*)(vcb + dt * 16 * 528 + 64 * step + 32);
        v4u u; u.x = lo.x; u.y = lo.y; u.z = hi.x; u.w = hi.y; vf[dt] = __builtin_bit_cast(bf16x8, u); }
}
__device__ __forceinline__ void cmp_item(Frame& F, int layer, int item) {
    constexpr float LOG2E_C = 1.4426950408889634f;
    const float m0c = WSP(float, WS_M0)[layer * 8 + 4];
    const bf16* P = WSP(bf16, WS_P); const bf16* KC = WSP(bf16, WS_KC); const bf16* VCT = WSP(bf16, WS_VCT);
    const float* BL = WSP(float, WS_BL); bf16* MIX = WSP(bf16, WS_MIX); u64* SEL = WSP(u64, WS_SEL);
    const int lane = F.lane, wave = F.wave, fr = lane & 15, fq = lane >> 4;
    const int bh = item >> 5, qt = item & 31, b = bh >> 1, hk = bh & 1;
    const int t0 = qt * 128 + wave * 16, t_ = t0 + fr;
    const size_t row = (size_t)b * T + t_;
    const int nlut = qt * 128 + 128;
    const int nmax = (t0 + 15 >= 31) ? ((t0 + 15 - 31) >> 4) : -1;
    float imp[16];
#pragma unroll
    for (int i = 0; i < 16; ++i) imp[i] = 0.f;
    LAS unsigned char* KL = F.lds; LAS unsigned char* VL = F.lds + 69632;
    __syncthreads();
    const int tidv = F.tid;
#pragma unroll
    for (int i = 0; i < 8; ++i) { const int c = tidv + i * 512, r = c >> 4, ch = c & 15;
        *(LAS v4u*)(KL + r * 272 + ch * 16) = *(const v4u*)(KC + (size_t)(bh * 256 + r) * 128 + ch * 8); }
#pragma unroll
    for (int i = 0; i < 8; ++i) { const int c = tidv + i * 512, r = c >> 5, ch = c & 31;
        *(LAS v4u*)(VL + r * 528 + ch * 16) = *(const v4u*)(VCT + (size_t)(bh * 128 + r) * 256 + ch * 8); }
    __syncthreads();
    const LAS unsigned char* kcb = KL + fr * 272 + fq * 16;
    const LAS unsigned char* vcb = VL + fr * 528 + fq * 8;
#pragma unroll 1
    for (int g = 0; g < 3; ++g) {
        const int h = hk * 3 + g;
        int t = t_; asm volatile("" : "+v"(t));
        bf16x8 qf[4];
#pragma unroll
        for (int ks = 0; ks < 4; ++ks) qf[ks] = *(const bf16x8*)(P + row * NP + C_QA + h * 128 + ks * 32 + fq * 8);
        LAS float* bl = (LAS float*)(F.lds + 137216);
        __syncthreads();
        { float lv[8];
#pragma unroll
          for (int u = 0; u < 8; ++u) lv[u] = BL[h * 4096 + ((F.tid + u * 512) & 4095)];
#pragma unroll
          for (int u = 0; u < 8; ++u) { const int i = F.tid + u * 512; if (i < nlut) bl[i] = lv[u] * LOG2E_C - m0c; } }
        __syncthreads();
        float l = 0.f; float impH[16];
#pragma unroll
        for (int i = 0; i < 16; ++i) impH[i] = 0.f;
        f32x4 O[8];
#pragma unroll
        for (int dt = 0; dt < 8; ++dt) O[dt] = (f32x4){0.f, 0.f, 0.f, 0.f};
        float prev3 = 0.f;
#pragma unroll
        for (int kt = 0; kt < 4; ++kt) {
            if (kt * 64 <= nmax) {
                f32x4 S[4]; bf16x8 fa[8], fb[8];
                cmp_loadk2(fa, kcb, kt * 4); CSB();
                cmp_loadk2(fb, kcb, kt * 4 + 2);
#pragma unroll
                for (int t = 0; t < 2; ++t) { S[t] = (f32x4){0.f, 0.f, 0.f, 0.f};
#pragma unroll
                    for (int ks = 0; ks < 4; ++ks) S[t] = __builtin_amdgcn_mfma_f32_16x16x32_bf16(fa[t * 4 + ks], qf[ks], S[t], 0, 0, 0); }
                CSB();
                cmp_loadv(fa, vcb, kt * 2);
#pragma unroll
                for (int t = 0; t < 2; ++t) { S[2 + t] = (f32x4){0.f, 0.f, 0.f, 0.f};
#pragma unroll
                    for (int ks = 0; ks < 4; ++ks) S[2 + t] = __builtin_amdgcn_mfma_f32_16x16x32_bf16(fb[t * 4 + ks], qf[ks], S[2 + t], 0, 0, 0); }
                CSB();
#pragma unroll
                for (int tl = 0; tl < 4; ++tl) {
#pragma unroll
                    for (int j = 0; j < 4; ++j) { const int n = kt * 64 + tl * 16 + fq * 4 + j, dist = t - (16 * n + 31);
                        const float pen = __builtin_bit_cast(float, (unsigned)(dist >> 31) & 0xff800000u);
                        const float e = __builtin_amdgcn_exp2f((S[tl][j] * (SCALE * LOG2E_C) + bl[dist > 0 ? dist : 0]) + pen); S[tl][j] = e; l += e; }
                    const float sh = __shfl(S[tl][3], (lane + 48) & 63);
                    const float nb = (fq == 0) ? prev3 : sh;
                    prev3 = sh;
                    impH[kt * 4 + tl] += 0.5f * nb + S[tl][0] + S[tl][1] + S[tl][2] + 0.5f * S[tl][3];
                }
                CSB();
#pragma unroll
                for (int s2 = 0; s2 < 2; ++s2) {
                    bf16x8 (&cur)[8] = s2 ? fb : fa;
                    if (s2 == 0) cmp_loadv(fb, vcb, kt * 2 + 1);
                    v4u pbu; pbu.x = pk2(S[2 * s2][0], S[2 * s2][1]); pbu.y = pk2(S[2 * s2][2], S[2 * s2][3]); pbu.z = pk2(S[2 * s2 + 1][0], S[2 * s2 + 1][1]); pbu.w = pk2(S[2 * s2 + 1][2], S[2 * s2 + 1][3]);
                    const bf16x8 pb = __builtin_bit_cast(bf16x8, pbu);
#pragma unroll
                    for (int dt = 0; dt < 8; ++dt) O[dt] = __builtin_amdgcn_mfma_f32_16x16x32_bf16(cur[dt], pb, O[dt], 0, 0, 0);
                    CSB();
                }
            }
            __builtin_amdgcn_sched_barrier(0);
        }
        l += __shfl_xor(l, 16); l += __shfl_xor(l, 32);
        const float inv = l > 0.f ? 1.f / l : 0.f;
#pragma unroll
        for (int i = 0; i < 16; ++i) imp[i] += impH[i] * inv;
        const float g0 = sigmoidf_(bf2f(P[row * NP + C_GA + h * 3 + 0])) * inv;
        bf16* op = MIX + row * DM + h * 128 + fq * 4;
#pragma unroll
        for (int dt = 0; dt < 8; ++dt) { v2u w; w.x = pk2(g0 * O[dt][0], g0 * O[dt][1]); w.y = pk2(g0 * O[dt][2], g0 * O[dt][3]); *(v2u*)(op + dt * 16) = w; }
    }
    LAS float* impS = (LAS float*)(F.lds) + wave * (16 * 65) + fr * 65;
    __syncthreads();
    const int t = t_, cur = t >> 6;
#pragma unroll
    for (int tl = 0; tl < 16; ++tl) { const int J = tl * 4 + fq; impS[J] = (J >= 1 && J <= cur - 2) ? imp[tl] : -INFINITY; }
    __syncthreads();
    int cnt[16];
#pragma unroll
    for (int tl = 0; tl < 16; ++tl) cnt[tl] = 0;
#pragma unroll 2
    for (int jp = 0; jp < 64; ++jp) { const float v = impS[jp];
#pragma unroll
        for (int tl = 0; tl < 16; ++tl) { const int J = tl * 4 + fq; cnt[tl] += (v > imp[tl] || (v == imp[tl] && jp < J)) ? 1 : 0; } }
    unsigned mlo = 0u, mhi = 0u;
#pragma unroll
    for (int tl = 0; tl < 16; ++tl) { const int J = tl * 4 + fq;
        const bool sel = (J <= cur) && (cur <= 15 || J == 0 || J >= cur - 1 || cnt[tl] < 13);
        if (sel) { if (tl < 8) mlo |= 1u << J; else mhi |= 1u << (J - 32); } }
    mlo |= __shfl_xor(mlo, 16); mlo |= __shfl_xor(mlo, 32); mhi |= __shfl_xor(mhi, 16); mhi |= __shfl_xor(mhi, 32);
    if (fq == 0) SEL[(size_t)bh * T + t] = ((u64)mhi << 32) | mlo;
}

constexpr int KS_OFF = 0, KS_STRIDE = 288, VS_OFF = 36864, VS_STRIDE = 288, LUT_OFF = 73728, LUT_MAX = 4352, UM_OFF = LUT_OFF + LUT_MAX * 4;
constexpr float LOG2E = 1.4426950408889634f, SC2 = SCALE * LOG2E, LN2 = 0.6931471805599453f;
constexpr int LUT_PAD = 96, LUT_EXTRA = 96;
struct KVSrc { const bf16* k; const bf16* v; int dil, res; };
__device__ __forceinline__ float xmax16(float v) { return fmaxf(v, __shfl_xor(v, 16)); }
__device__ __forceinline__ float xmax32(float v) { return fmaxf(v, __shfl_xor(v, 32)); }
__device__ __forceinline__ float xsum16(float v) { return v + __shfl_xor(v, 16); }
__device__ __forceinline__ float xsum32(float v) { return v + __shfl_xor(v, 32); }

template <int NU = 9>
__device__ __forceinline__ void build_lut(Frame& F, int h, int dil, int maxd, float m0 = 0.f) {
    const float* bl = WSP(float, WS_BL) + h * 4096; LAS float* LUT = (LAS float*)(F.lds + LUT_OFF);
    const int RB = maxd + LUT_EXTRA, n = RB + LUT_PAD;
    __syncthreads();
    float v[NU];
#pragma unroll
    for (int u = 0; u < NU; ++u) { const int d = RB - (F.tid + u * 512), dc = d < 0 ? 0 : (d > maxd ? maxd : d); v[u] = bl[dc * dil]; }
#pragma unroll
    for (int u = 0; u < NU; ++u) { const int i = F.tid + u * 512, d = RB - i; if (i < n) LUT[i] = (d >= 0 && d <= maxd) ? v[u] * LOG2E - m0 : -m0; }
    __syncthreads();
}

#define FSB() __builtin_amdgcn_sched_barrier(0)
__device__ __forceinline__ void loadk2(bf16x8 (&kf)[8], const LAS unsigned char* kb, int p) {
#pragma unroll
    for (int t = 0; t < 2; ++t)
#pragma unroll
        for (int ks = 0; ks < 4; ++ks) kf[t * 4 + ks] = *(const LAS bf16x8*)(kb + (2 * p + t) * 16 * KS_STRIDE + ks * 64);
}
__device__ __forceinline__ void loadv(bf16x8 (&vf)[8], const LAS unsigned char* vb, int s) {
#pragma unroll
    for (int dt = 0; dt < 8; ++dt) { const s16x4 lo = vtr(vb + (32 * s) * VS_STRIDE + dt * 32), hi = vtr(vb + (32 * s + 16) * VS_STRIDE + dt * 32);
        vf[dt] = (bf16x8){lo[0], lo[1], lo[2], lo[3], hi[0], hi[1], hi[2], hi[3]}; }
}
template <int MODE, int NH>
__device__ __forceinline__ void flash_step(f32x4 (&O)[8], float& m, float& l, const bf16x8 (&qf)[4], const LAS unsigned char* kb, const LAS unsigned char* vb,
                                           const LAS float* lp, int d0, bool interior, int W, bool mb0, bool mb1) {
    constexpr int NT = NH * 4, NS = NH * 2;
    f32x4 S[NT];
    bf16x8 fa[8], fb[8];
    loadk2(fa, kb, 0);
    FSB();
#pragma unroll
    for (int p = 0; p < NT / 2; ++p) {
        bf16x8 (&cur)[8] = (p & 1) ? fb : fa; bf16x8 (&nxt)[8] = (p & 1) ? fa : fb;
        if (p + 1 < NT / 2) loadk2(nxt, kb, p + 1); else loadv(nxt, vb, 0);
#pragma unroll
        for (int t = 0; t < 2; ++t) { S[2 * p + t] = (f32x4){0.f, 0.f, 0.f, 0.f};
#pragma unroll
            for (int ks = 0; ks < 4; ++ks) S[2 * p + t] = __builtin_amdgcn_mfma_f32_16x16x32_bf16(cur[t * 4 + ks], qf[ks], S[2 * p + t], 0, 0, 0); }
        FSB();
    }
    float rs0 = 0.f, rs1 = 0.f;
    if (interior) {
#pragma unroll
        for (int tl = 0; tl < NT; ++tl)
#pragma unroll
            for (int j = 0; j < 4; ++j) { const float e = __builtin_amdgcn_exp2f(S[tl][j] * SC2 + lp[tl * 16 + j]); S[tl][j] = e; if (tl < 4) rs0 += e; else rs1 += e; }
    } else {
#pragma unroll
        for (int tl = 0; tl < NT; ++tl)
#pragma unroll
            for (int j = 0; j < 4; ++j) { const int dist = d0 - (tl * 16 + j);
                const int bad = (MODE == 0) ? ((dist >> 31) | ((W - dist) >> 31)) : (dist >> 31);
                const float pen = __builtin_bit_cast(float, (unsigned)bad & 0xff800000u);
                const float e = __builtin_amdgcn_exp2f((S[tl][j] * SC2 + lp[tl * 16 + j]) + pen); S[tl][j] = e; if (tl < 4) rs0 += e; else rs1 += e; }
    }
    if (MODE == 1) { rs0 = mb0 ? rs0 : 0.f; rs1 = mb1 ? rs1 : 0.f; }
    l += rs0 + rs1;
    FSB();
#pragma unroll
    for (int s = 0; s < NS; ++s) {
        bf16x8 (&cur)[8] = (s & 1) ? fb : fa; bf16x8 (&nxt)[8] = (s & 1) ? fa : fb;
        if (s + 1 < NS) loadv(nxt, vb, s + 1);
        v4u pbu; pbu.x = pk2(S[2 * s][0], S[2 * s][1]); pbu.y = pk2(S[2 * s][2], S[2 * s][3]); pbu.z = pk2(S[2 * s + 1][0], S[2 * s + 1][1]); pbu.w = pk2(S[2 * s + 1][2], S[2 * s + 1][3]);
        if (MODE == 1) { const bool mb = (s < 2) ? mb0 : mb1; if (!mb) pbu = (v4u){0u, 0u, 0u, 0u}; }
        const bf16x8 pb = __builtin_bit_cast(bf16x8, pbu);
#pragma unroll
        for (int dt = 0; dt < 8; ++dt) O[dt] = __builtin_amdgcn_mfma_f32_16x16x32_bf16(cur[dt], pb, O[dt], 0, 0, 0);
        FSB();
    }
}

template <int MODE>
__device__ __forceinline__ void flash(Frame& F, f32x4 (&O)[8], float& m, float& l, const bf16x8 (&qf)[4], const KVSrc kv, int q0, int W, int RB, u64 sel, u64 umask, int lut_h = -1, float m0 = 0.f) {
    const int tid = F.tid, lane = F.lane, wave = F.wave, fr = lane & 15, fq = lane >> 4;
    LAS unsigned char* KS = F.lds + KS_OFF; LAS unsigned char* VS = F.lds + VS_OFF; const LAS float* LUT = (const LAS float*)(F.lds + LUT_OFF);
    const int wq0 = q0 + wave * 16, sq = wq0 + fr;
    int kt_lo = 0; const int kt_hi = (q0 + 127) >> 7;
    if (MODE == 0) { const int lo = q0 - W; kt_lo = lo > 0 ? (lo >> 7) : 0; }
#pragma unroll
    for (int dt = 0; dt < 8; ++dt) O[dt] = (f32x4){0.f, 0.f, 0.f, 0.f};
    m = m0; l = 0.f;
    const int r0 = tid >> 4, ch = tid & 15;
    int kt = kt_lo;
    if (MODE == 1) { while (kt <= kt_hi && !((umask >> (2 * kt)) & 3ull)) ++kt; }
    v4u pk[4], pv[4];
    if (kt <= kt_hi) {
#pragma unroll
        for (int i = 0; i < 4; ++i) { const size_t to = (size_t)((kt * 128 + r0 + 32 * i) * kv.dil + kv.res) * NP + ch * 8; pk[i] = *(const v4u*)(kv.k + to); pv[i] = *(const v4u*)(kv.v + to); }
    }
    if (lut_h >= 0) build_lut<1>(F, lut_h, kv.dil, W, m0);
    const LAS unsigned char* kb = KS + fr * KS_STRIDE + fq * 16;
    const LAS unsigned char* vb = VS + (fq * 4 + (fr >> 2)) * VS_STRIDE + (fr & 3) * 8;
    while (kt <= kt_hi) {
        __syncthreads();
#pragma unroll
        for (int i = 0; i < 4; ++i) { *(LAS v4u*)(KS + (r0 + 32 * i) * KS_STRIDE + ch * 16) = pk[i]; *(LAS v4u*)(VS + (r0 + 32 * i) * VS_STRIDE + ch * 16) = pv[i]; }
        __syncthreads();
        int nk = kt + 1;
        if (MODE == 1) { while (nk <= kt_hi && !((umask >> (2 * nk)) & 3ull)) ++nk; }
        if (nk <= kt_hi) {
#pragma unroll
            for (int i = 0; i < 4; ++i) { const size_t to = (size_t)((nk * 128 + r0 + 32 * i) * kv.dil + kv.res) * NP + ch * 8; pk[i] = *(const v4u*)(kv.k + to); pv[i] = *(const v4u*)(kv.v + to); }
        }
        const int key0 = kt * 128;
        const bool mb0 = (MODE == 1) ? (((sel >> (2 * kt)) & 1ull) != 0ull) : true, mb1 = (MODE == 1) ? (((sel >> (2 * kt + 1)) & 1ull) != 0ull) : true;
        bool nh0 = (wq0 + 15 >= key0), nh1 = (wq0 + 15 >= key0 + 64);
        if (MODE == 0) { nh0 = nh0 && (wq0 - (key0 + 63) <= W); nh1 = nh1 && (wq0 - (key0 + 127) <= W); }
        if (MODE == 1) { nh0 = nh0 && (__ballot(mb0) != 0ull); nh1 = nh1 && (__ballot(mb1) != 0ull); }
        if (nh0 && nh1) {
            const int dmin = wq0 - (key0 + 127), dmax = wq0 + 15 - key0;
            const bool interior = (dmin >= 0) && (MODE == 1 || dmax <= W);
            flash_step<MODE, 2>(O, m, l, qf, kb, vb, LUT + (RB - sq + key0 + fq * 4), sq - (key0 + fq * 4), interior, W, mb0, mb1);
        } else if (nh0) {
            const int dmin = wq0 - (key0 + 63), dmax = wq0 + 15 - key0;
            const bool interior = (dmin >= 0) && (MODE == 1 || dmax <= W);
            flash_step<MODE, 1>(O, m, l, qf, kb, vb, LUT + (RB - sq + key0 + fq * 4), sq - (key0 + fq * 4), interior, W, mb0, mb0);
        } else if (nh1) {
            const int dmin = wq0 - (key0 + 127), dmax = wq0 + 15 - (key0 + 64);
            const bool interior = (dmin >= 0) && (MODE == 1 || dmax <= W);
            flash_step<MODE, 1>(O, m, l, qf, kb + 64 * KS_STRIDE, vb + 64 * VS_STRIDE, LUT + (RB - sq + key0 + 64 + fq * 4), sq - (key0 + 64 + fq * 4), interior, W, mb1, mb1);
        }
        kt = nk;
    }
    l = xsum32(xsum16(l));
}
__device__ __forceinline__ void load_q(bf16x8 (&qf)[4], const bf16* qrow, int fq) {
#pragma unroll
    for (int ks = 0; ks < 4; ++ks) qf[ks] = *(const bf16x8*)(qrow + ks * 32 + fq * 8);
}

__device__ __forceinline__ void b_item(Frame& F, int layer, int item) {
    const bf16* P = WSP(bf16, WS_P); bf16* MIX = WSP(bf16, WS_MIX);
    const int fr = F.lane & 15, fq = F.lane >> 4;
    const int qt = item & 31, hb = (item >> 5) & 3, b = item >> 7;
    const int q0 = qt * 128, t = q0 + F.wave * 16 + fr; const size_t row = (size_t)b * T + t;
    const float m0 = WSP(float, WS_M0)[layer * 8 + 2];
    bf16x8 qf[4]; load_q(qf, P + row * NP + C_QB + hb * 128, fq);
    const KVSrc kv{P + (size_t)b * T * NP + C_KB + (hb >> 1) * 128, P + (size_t)b * T * NP + C_VB + (hb >> 1) * 128, 1, 0};
    f32x4 O[8]; float m, l;
    flash<0>(F, O, m, l, qf, kv, q0, 127, 127 + LUT_EXTRA, 0ull, 0ull, 6 + hb, m0);
    const float sink = F.a->sinks[layer * 4 + hb];
    const float inv = 1.f / (l + __builtin_amdgcn_exp2f(sink * LOG2E - m));
    bf16* op = MIX + row * DM + (6 + hb) * 128 + fq * 4;
#pragma unroll
    for (int dt = 0; dt < 8; ++dt) { v2u w; w.x = pk2(O[dt][0] * inv, O[dt][1] * inv); w.y = pk2(O[dt][2] * inv, O[dt][3] * inv); *(v2u*)(op + dt * 16) = w; }
}
__device__ __forceinline__ void c_item(Frame& F, int layer, int item) {
    const bf16* P = WSP(bf16, WS_P); bf16* MIX = WSP(bf16, WS_MIX); float* LSE = WSP(float, WS_LSE);
    const int fr = F.lane & 15, fq = F.lane >> 4;
    const int g = item >> 8, idx = item & 255, j = idx & 1, b = (idx >> 1) & 3, r2 = idx >> 3;
    const int dil = (g == 0) ? 1 : (g == 1 ? 4 : 16), res = r2 % dil, qt = r2 / dil;
    const int q0 = qt * 128, sq = q0 + F.wave * 16 + fr, t = sq * dil + res; const size_t row = (size_t)b * T + t;
    const int hq = 2 * g + j;
    const float m0 = WSP(float, WS_M0)[layer * 8 + 3];
    bf16x8 qf[4]; load_q(qf, P + row * NP + C_QC + hq * 128, fq);
    const KVSrc kv{P + (size_t)b * T * NP + C_KC + g * 128, P + (size_t)b * T * NP + C_VC + g * 128, dil, res};
    f32x4 O[8]; float m, l;
    flash<0>(F, O, m, l, qf, kv, q0, 128, 128 + LUT_EXTRA, 0ull, 0ull, 10 + hq, m0);
    const float inv = 1.f / l;
    bf16* op = MIX + row * DM + (10 + hq) * 128 + fq * 4;
#pragma unroll
    for (int dt = 0; dt < 8; ++dt) { v2u w; w.x = pk2(O[dt][0] * inv, O[dt][1] * inv); w.y = pk2(O[dt][2] * inv, O[dt][3] * inv); *(v2u*)(op + dt * 16) = w; }
    if (fq == 0) LSE[row * 6 + hq] = (m + __log2f(l)) * LN2;
}
__device__ __forceinline__ void a_item(Frame& F, int item, bool dry) {
    const bf16* P = WSP(bf16, WS_P); bf16* MIX = WSP(bf16, WS_MIX); const u64* SEL = WSP(u64, WS_SEL);
    const int lane = F.lane, fr = lane & 15, fq = lane >> 4;
    const int bh6 = item % 24, qt = 31 - item / 24, b = bh6 / 6, h = bh6 % 6, hk = h / 3;
    const int q0 = qt * 128, t = q0 + F.wave * 16 + fr; const size_t row = (size_t)b * T + t;
    const u64 sel = SEL[(size_t)(b * 2 + hk) * T + t];
    unsigned ulo = (unsigned)sel, uhi = (unsigned)(sel >> 32);
#pragma unroll
    for (int o = 1; o < 64; o <<= 1) { ulo |= __shfl_xor(ulo, o); uhi |= __shfl_xor(uhi, o); }
    LAS unsigned* UM = (LAS unsigned*)(F.lds + UM_OFF);
    __syncthreads();
    if (lane == 0) { UM[F.wave * 2] = ulo; UM[F.wave * 2 + 1] = uhi; }
    build_lut(F, h, 1, q0 + 127);
    unsigned alo = 0u, ahi = 0u;
#pragma unroll
    for (int w = 0; w < 8; ++w) { alo |= UM[w * 2]; ahi |= UM[w * 2 + 1]; }
    const u64 umask = ((u64)ahi << 32) | alo;
    bf16x8 qf[4]; load_q(qf, P + row * NP + C_QA + h * 128, fq);
    const bf16* pb = P + (size_t)b * T * NP;
    bf16* op = MIX + row * DM + h * 128 + fq * 4;
    {   f32x4 O1[8]; float m1, l1;
        const KVSrc kv{pb + C_KSA + hk * 128, pb + C_VSA + hk * 128, 1, 0}; flash<1>(F, O1, m1, l1, qf, kv, q0, 0, q0 + 127 + LUT_EXTRA, sel, umask);
        const float g1 = sigmoidf_(bf2f(P[row * NP + C_GA + h * 3 + 1])) / l1;
#pragma unroll
        for (int dt = 0; dt < 8; ++dt) { const v2u c = *(const v2u*)(op + dt * 16);
            v2u w; w.x = pk2(bflo(c.x) + g1 * O1[dt][0], bfhi(c.x) + g1 * O1[dt][1]); w.y = pk2(bflo(c.y) + g1 * O1[dt][2], bfhi(c.y) + g1 * O1[dt][3]); if (!dry) *(v2u*)(op + dt * 16) = w; }
    }
    build_lut(F, h, 1, 511);
    {   f32x4 O2[8]; float m2, l2;
        const KVSrc kv{pb + C_KWA + hk * 128, pb + C_VWA + hk * 128, 1, 0}; flash<0>(F, O2, m2, l2, qf, kv, q0, 511, 511 + LUT_EXTRA, 0ull, 0ull);
        const float g2 = sigmoidf_(bf2f(P[row * NP + C_GA + h * 3 + 2])) / l2;
#pragma unroll
        for (int dt = 0; dt < 8; ++dt) { const v2u c = *(const v2u*)(op + dt * 16);
            v2u w; w.x = pk2(bflo(c.x) + g2 * O2[dt][0], bfhi(c.x) + g2 * O2[dt][1]); w.y = pk2(bflo(c.y) + g2 * O2[dt][2], bfhi(c.y) + g2 * O2[dt][3]); if (!dry) *(v2u*)(op + dt * 16) = w; }
    }
}
typedef float f32x16 __attribute__((ext_vector_type(16)));
constexpr int R32_SLOT = 32768, R32_NSLOT = 4, R32_V = 16384, LUT32_OFF = R32_NSLOT * R32_SLOT, UM32_OFF = LUT32_OFF + LUT_MAX * 4;
__device__ __forceinline__ void k32_load4(bf16x8 (&kf)[4], const LAS unsigned char* slot, const int (&koff)[8], int tile, int c) {
#pragma unroll
    for (int k = 0; k < 4; ++k) kf[k] = *(const LAS bf16x8*)(slot + koff[4 * c + k] + tile * 8192);
}
__device__ __forceinline__ void v32_load(bf16x8 (&vf)[4], const LAS unsigned char* slot, const int (&voff)[4], int ts) {
#pragma unroll
    for (int dt = 0; dt < 4; ++dt) { const s16x4 lo = vtr(slot + R32_V + voff[dt] + (16 * ts) * 256), hi = vtr(slot + R32_V + voff[dt] + (16 * ts + 8) * 256);
        vf[dt] = (bf16x8){lo[0], lo[1], lo[2], lo[3], hi[0], hi[1], hi[2], hi[3]}; }
}
template <int MODE>
__device__ __forceinline__ void flash32_p1(f32x16 (&O)[4], float& m, float& l, f32x16& S0, f32x16& S1, const bf16x8 (&qf)[8], const LAS unsigned char* slot, const int (&koff)[8],
                                           const LAS float* lp, int d0, bool interior, int W, bool mb) {
    const f32x16 Z = {0.f, 0.f, 0.f, 0.f, 0.f, 0.f, 0.f, 0.f, 0.f, 0.f, 0.f, 0.f, 0.f, 0.f, 0.f, 0.f};
    bf16x8 ka[4], kbf[4];
    f32x16 A0, A1;
    k32_load4(ka, slot, koff, 0, 0);
    FSB();
    k32_load4(kbf, slot, koff, 0, 1);
    __builtin_amdgcn_s_setprio(1);
    A0 = __builtin_amdgcn_mfma_f32_32x32x16_bf16(ka[0], qf[0], Z, 0, 0, 0);
#pragma unroll
    for (int k = 1; k < 4; ++k) A0 = __builtin_amdgcn_mfma_f32_32x32x16_bf16(ka[k], qf[k], A0, 0, 0, 0);
    FSB();
    k32_load4(ka, slot, koff, 1, 0);
#pragma unroll
    for (int k = 0; k < 4; ++k) A0 = __builtin_amdgcn_mfma_f32_32x32x16_bf16(kbf[k], qf[4 + k], A0, 0, 0, 0);
    FSB();
    k32_load4(kbf, slot, koff, 1, 1);
    A1 = __builtin_amdgcn_mfma_f32_32x32x16_bf16(ka[0], qf[0], Z, 0, 0, 0);
#pragma unroll
    for (int k = 1; k < 4; ++k) A1 = __builtin_amdgcn_mfma_f32_32x32x16_bf16(ka[k], qf[k], A1, 0, 0, 0);
    FSB();
#pragma unroll
    for (int k = 0; k < 4; ++k) A1 = __builtin_amdgcn_mfma_f32_32x32x16_bf16(kbf[k], qf[4 + k], A1, 0, 0, 0);
    __builtin_amdgcn_s_setprio(0);
    FSB();
    float rs = 0.f;
    if (interior) {
#pragma unroll
        for (int i = 0; i < 16; ++i) { const float e = __builtin_amdgcn_exp2f(A0[i] * SC2 + lp[(i & 3) + 8 * (i >> 2)]); A0[i] = e; rs += e; }
#pragma unroll
        for (int i = 0; i < 16; ++i) { const float e = __builtin_amdgcn_exp2f(A1[i] * SC2 + lp[32 + (i & 3) + 8 * (i >> 2)]); A1[i] = e; rs += e; }
    } else {
#pragma unroll
        for (int i = 0; i < 16; ++i) { const int ko = (i & 3) + 8 * (i >> 2), dist = d0 - ko;
            const int bad = (MODE == 0) ? ((dist >> 31) | ((W - dist) >> 31)) : (dist >> 31);
            const float pen = __builtin_bit_cast(float, (unsigned)bad & 0xff800000u);
            const float e = __builtin_amdgcn_exp2f((A0[i] * SC2 + lp[ko]) + pen); A0[i] = e; rs += e; }
#pragma unroll
        for (int i = 0; i < 16; ++i) { const int ko = 32 + (i & 3) + 8 * (i >> 2), dist = d0 - ko;
            const int bad = (MODE == 0) ? ((dist >> 31) | ((W - dist) >> 31)) : (dist >> 31);
            const float pen = __builtin_bit_cast(float, (unsigned)bad & 0xff800000u);
            const float e = __builtin_amdgcn_exp2f((A1[i] * SC2 + lp[ko]) + pen); A1[i] = e; rs += e; }
    }
    if (MODE == 1) rs = mb ? rs : 0.f;
    l += rs;
    S0 = A0; S1 = A1;
    FSB();
}
template <int MODE>
__device__ __forceinline__ void flash32_p2(f32x16 (&O)[4], const f32x16& S0, const f32x16& S1, const LAS unsigned char* slot, const int (&voff)[4], bool mb) {
    bf16x8 va[4], vbf[4];
    v32_load(va, slot, voff, 0);
    FSB();
    __builtin_amdgcn_s_setprio(1);
#pragma unroll
    for (int ts = 0; ts < 4; ++ts) {
        bf16x8 (&cur)[4] = (ts & 1) ? vbf : va; bf16x8 (&nxt)[4] = (ts & 1) ? va : vbf;
        if (ts + 1 < 4) v32_load(nxt, slot, voff, ts + 1);
        const f32x16& St = (ts >> 1) ? S1 : S0; const int o = 8 * (ts & 1);
        v4u pbu; pbu.x = pk2(St[o], St[o + 1]); pbu.y = pk2(St[o + 2], St[o + 3]); pbu.z = pk2(St[o + 4], St[o + 5]); pbu.w = pk2(St[o + 6], St[o + 7]);
        if (MODE == 1) { if (!mb) pbu = (v4u){0u, 0u, 0u, 0u}; }
        const bf16x8 pb = __builtin_bit_cast(bf16x8, pbu);
#pragma unroll
        for (int dt = 0; dt < 4; ++dt) O[dt] = __builtin_amdgcn_mfma_f32_32x32x16_bf16(cur[dt], pb, O[dt], 0, 0, 0);
        FSB();
    }
    __builtin_amdgcn_s_setprio(0);
}
template <int MODE, bool LAG>
__device__ __forceinline__ void flash32_loop(LAS unsigned char* lds, f32x16 (&O)[4], float& m, float& l, const bf16x8 (&qf)[8], const int (&koff)[8], const int (&voff)[4],
                                             const size_t (&gk)[2], const size_t (&gv)[2], const char* kbase, const char* vbase, size_t tstep, int k0, int k1, int kt_hi,
                                             u64 umask, u64 sel, int wq0, int sq, int RB, int W, const LAS float* LUT, int h, int wave) {
#define R32_ISSUE(ktile_, slot_) do { const char* kp_ = kbase + (size_t)(ktile_) * tstep; const char* vp_ = vbase + (size_t)(ktile_) * tstep; \
        LAS unsigned char* sb_ = lds + (slot_) * R32_SLOT + (2 * wave) * 1024; \
        __builtin_amdgcn_global_load_lds((const unsigned*)(kp_ + gk[0]), (LAS unsigned*)(sb_), 16, 0, 0); \
        __builtin_amdgcn_global_load_lds((const unsigned*)(kp_ + gk[1]), (LAS unsigned*)(sb_ + 1024), 16, 0, 0); \
        __builtin_amdgcn_global_load_lds((const unsigned*)(vp_ + gv[0]), (LAS unsigned*)(sb_ + R32_V), 16, 0, 0); \
        __builtin_amdgcn_global_load_lds((const unsigned*)(vp_ + gv[1]), (LAS unsigned*)(sb_ + R32_V + 1024), 16, 0, 0); } while (0)
#define R32_NEXT(k_) do { ++(k_); if (MODE == 1) { while ((k_) <= kt_hi && !((umask >> (k_)) & 1ull)) ++(k_); } } while (0)
    int slot = 0; bool pneed = false, pmb = false; int pslot = 0;
    f32x16 S0, S1;
#pragma unroll
    for (int i = 0; i < 16; ++i) { S0[i] = 0.f; S1[i] = 0.f; }
    while (k0 <= kt_hi) {
        int k2 = k1; if (k1 <= kt_hi) R32_NEXT(k2);
        if (k1 <= kt_hi) asm volatile("s_waitcnt vmcnt(4)" ::: "memory"); else asm volatile("s_waitcnt vmcnt(0)" ::: "memory");
        __builtin_amdgcn_s_barrier();
        __builtin_amdgcn_sched_barrier(0);
        if (k2 <= kt_hi) { const int s2 = slot + 2 >= R32_NSLOT ? slot + 2 - R32_NSLOT : slot + 2; R32_ISSUE(k2, s2); }
        const int key0 = k0 * 64;
        const bool mb = (MODE == 1) ? (((sel >> k0) & 1ull) != 0ull) : true;
        bool need = (wq0 + 31 >= key0);
        if (MODE == 0) need = need && (wq0 - (key0 + 63) <= W);
        if (MODE == 1) need = need && (__ballot(mb) != 0ull);
        const int dmin = wq0 - (key0 + 63), dmax = wq0 + 31 - key0;
        const bool interior = (dmin >= 0) && (MODE == 1 || dmax <= W);
        if (!LAG) { if (need) { flash32_p1<MODE>(O, m, l, S0, S1, qf, lds + slot * R32_SLOT, koff, LUT + (RB - sq + key0 + 4 * h), sq - (key0 + 4 * h), interior, W, mb);
                                flash32_p2<MODE>(O, S0, S1, lds + slot * R32_SLOT, voff, mb); } }
        else { if (pneed) flash32_p2<MODE>(O, S0, S1, lds + pslot * R32_SLOT, voff, pmb);
               if (need) flash32_p1<MODE>(O, m, l, S0, S1, qf, lds + slot * R32_SLOT, koff, LUT + (RB - sq + key0 + 4 * h), sq - (key0 + 4 * h), interior, W, mb);
               pneed = need; pmb = mb; pslot = slot; }
        k0 = k1; k1 = k2; slot = slot + 1 >= R32_NSLOT ? 0 : slot + 1;
    }
    if (LAG) { if (pneed) flash32_p2<MODE>(O, S0, S1, lds + pslot * R32_SLOT, voff, pmb); }
}
__device__ __forceinline__ void build_lut32(Frame& F, int h, int maxd, float m0);
template <int MODE>
__device__ __forceinline__ void flash32(Frame& F, f32x16 (&O)[4], float& m, float& l, const bf16x8 (&qf)[8], const KVSrc kv, int q0, int W, int RB, u64 sel, u64 umask, int lut_h, int lut_maxd, float m0) {
    const int lane = F.lane, wave = F.wave, r = lane & 31, h = lane >> 5;
    const LAS float* LUT = (const LAS float*)(F.lds + LUT32_OFF);
    const int wq0 = q0 + wave * 32, sq = wq0 + r;
    int kt_lo = 0; const int kt_hi = (q0 + 255) >> 6;
    if (MODE == 0) { const int lo = q0 - W; kt_lo = lo > 0 ? (lo >> 6) : 0; }
#pragma unroll
    for (int dt = 0; dt < 4; ++dt) { for (int i = 0; i < 16; ++i) O[dt][i] = 0.f; }
    l = 0.f;
    int koff[8], voff[4];
#pragma unroll
    for (int ds = 0; ds < 8; ++ds) koff[ds] = r * 256 + ((((ds << 1) | h) ^ (r & 15)) << 4);
    { const int i16 = lane & 15, g = lane >> 4, q = i16 >> 2;
#pragma unroll
      for (int dt = 0; dt < 4; ++dt) voff[dt] = (4 * h + q) * 256 + ((dt ^ q) << 6) + (g & 1) * 32 + (i16 & 3) * 8; }
    size_t gk[2], gv[2];
#pragma unroll
    for (int i = 0; i < 2; ++i) { const int row = 4 * (2 * wave + i) + (lane >> 4), cs = lane & 15;
        gk[i] = (size_t)(row * kv.dil) * NP * 2 + (size_t)((cs ^ (row & 15)) << 4); gv[i] = (size_t)(row * kv.dil) * NP * 2 + (size_t)((cs ^ ((row & 3) << 2)) << 4); }
    const char* kbase = (const char*)kv.k + (size_t)kv.res * NP * 2; const char* vbase = (const char*)kv.v + (size_t)kv.res * NP * 2;
    const size_t tstep = (size_t)64 * kv.dil * NP * 2;
    int k0 = kt_lo - 1; R32_NEXT(k0);
    int k1 = k0; if (k0 <= kt_hi) R32_NEXT(k1);
    __syncthreads();
    { LAS unsigned char* lds = F.lds;
      if (k0 <= kt_hi) R32_ISSUE(k0, 0);
      if (k1 <= kt_hi) R32_ISSUE(k1, 1); }
    build_lut32(F, lut_h, lut_maxd, m0);
    if (wave >= 4) flash32_loop<MODE, true>(F.lds, O, m, l, qf, koff, voff, gk, gv, kbase, vbase, tstep, k0, k1, kt_hi, umask, sel, wq0, sq, RB, W, LUT, h, wave);
    else flash32_loop<MODE, false>(F.lds, O, m, l, qf, koff, voff, gk, gv, kbase, vbase, tstep, k0, k1, kt_hi, umask, sel, wq0, sq, RB, W, LUT, h, wave);
#undef R32_ISSUE
#undef R32_NEXT
    __syncthreads();
    l += __shfl_xor(l, 32);
}
__device__ __forceinline__ void build_lut32(Frame& F, int h, int maxd, float m0) {
    const float* bl = WSP(float, WS_BL) + h * 4096; LAS float* LUT = (LAS float*)(F.lds + LUT32_OFF);
    const int RB = maxd + LUT_EXTRA, n = RB + LUT_PAD;
    __syncthreads();
    float v[9];
#pragma unroll
    for (int u = 0; u < 9; ++u) { const int d = RB - (F.tid + u * 512), dc = d < 0 ? 0 : (d > maxd ? maxd : d); v[u] = bl[dc]; }
#pragma unroll
    for (int u = 0; u < 9; ++u) { const int i = F.tid + u * 512, d = RB - i; if (i < n) LUT[i] = (d >= 0 && d <= maxd) ? v[u] * LOG2E - m0 : -m0; }
    __syncthreads();
}
__device__ __forceinline__ void a_item32(Frame& F, int layer, int item) {
    const bf16* P = WSP(bf16, WS_P); bf16* MIX = WSP(bf16, WS_MIX); const u64* SEL = WSP(u64, WS_SEL);
    const int lane = F.lane, r = lane & 31, hh = lane >> 5;
    const int bh6 = item % 24, qt = 15 - item / 24, b = bh6 / 6, h = bh6 % 6, hk = h / 3;
    const int q0 = qt * 256, t = q0 + F.wave * 32 + r; const size_t row = (size_t)b * T + t;
    const u64 sel = SEL[(size_t)(b * 2 + hk) * T + t];
    unsigned ulo = (unsigned)sel, uhi = (unsigned)(sel >> 32);
#pragma unroll
    for (int o = 1; o < 64; o <<= 1) { ulo |= __shfl_xor(ulo, o); uhi |= __shfl_xor(uhi, o); }
    LAS unsigned* UM = (LAS unsigned*)(F.lds + UM32_OFF);
    __syncthreads();
    if (lane == 0) { UM[F.wave * 2] = ulo; UM[F.wave * 2 + 1] = uhi; }
    const float m0s = WSP(float, WS_M0)[layer * 8 + 0], m0w = WSP(float, WS_M0)[layer * 8 + 1];
    __syncthreads();
    unsigned alo = 0u, ahi = 0u;
#pragma unroll
    for (int w = 0; w < 8; ++w) { alo |= UM[w * 2]; ahi |= UM[w * 2 + 1]; }
    const u64 umask = ((u64)ahi << 32) | alo;
    bf16x8 qf[8];
#pragma unroll
    for (int ks = 0; ks < 8; ++ks) qf[ks] = *(const bf16x8*)(P + row * NP + C_QA + h * 128 + ks * 16 + hh * 8);
    const bf16* pb = P + (size_t)b * T * NP;
    {   f32x16 O1[4]; float m1, l1;
        const KVSrc kv{pb + C_KSA + hk * 128, pb + C_VSA + hk * 128, 1, 0}; flash32<1>(F, O1, m1, l1, qf, kv, q0, 0, q0 + 255 + LUT_EXTRA, sel, umask, h, q0 + 255, m0s);
        int l2 = threadIdx.x & 63; asm volatile("" : "+v"(l2));
        const size_t row2 = (size_t)b * T + q0 + F.wave * 32 + (l2 & 31);
        bf16* op = MIX + row2 * DM + h * 128 + 4 * (l2 >> 5);
        const float g1 = sigmoidf_(bf2f(P[row2 * NP + C_GA + h * 3 + 1])) / l1;
#pragma unroll
        for (int dt = 0; dt < 4; ++dt)
#pragma unroll
            for (int gq = 0; gq < 4; ++gq) { bf16* p = op + dt * 32 + 8 * gq; const v2u c = *(const v2u*)p;
                v2u w; w.x = pk2(bflo(c.x) + g1 * O1[dt][4 * gq], bfhi(c.x) + g1 * O1[dt][4 * gq + 1]); w.y = pk2(bflo(c.y) + g1 * O1[dt][4 * gq + 2], bfhi(c.y) + g1 * O1[dt][4 * gq + 3]); *(v2u*)p = w; }
    }
    {   f32x16 O2[4]; float m2, l2;
        const KVSrc kv{pb + C_KWA + hk * 128, pb + C_VWA + hk * 128, 1, 0}; flash32<0>(F, O2, m2, l2, qf, kv, q0, 511, 511 + LUT_EXTRA, 0ull, 0ull, h, 511, m0w);
        int l3 = threadIdx.x & 63; asm volatile("" : "+v"(l3));
        const size_t row2 = (size_t)b * T + q0 + F.wave * 32 + (l3 & 31);
        bf16* op = MIX + row2 * DM + h * 128 + 4 * (l3 >> 5);
        const float g2 = sigmoidf_(bf2f(P[row2 * NP + C_GA + h * 3 + 2])) / l2;
#pragma unroll
        for (int dt = 0; dt < 4; ++dt)
#pragma unroll
            for (int gq = 0; gq < 4; ++gq) { bf16* p = op + dt * 32 + 8 * gq; const v2u c = *(const v2u*)p;
                v2u w; w.x = pk2(bflo(c.x) + g2 * O2[dt][4 * gq], bfhi(c.x) + g2 * O2[dt][4 * gq + 1]); w.y = pk2(bflo(c.y) + g2 * O2[dt][4 * gq + 2], bfhi(c.y) + g2 * O2[dt][4 * gq + 3]); *(v2u*)p = w; }
    }
}
__device__ __forceinline__ void ccombine_phase(Frame& F) {
    bf16* MIX = WSP(bf16, WS_MIX); const float* LSE = WSP(float, WS_LSE);
    const int gw = F.bid * NWAVES + F.wave, NGW = F.G * NWAVES, sub = F.lane & 15, quad = F.lane >> 4;
    const int total = M * 6 / 4;
    constexpr int U = 4;
    for (int base = gw; base < total; base += NGW * U) {
        v4u w[U]; bf16* pp[U]; float al[U]; bool ok[U];
#pragma unroll
        for (int u = 0; u < U; ++u) {
            const int wi = base + u * NGW; ok[u] = wi < total;
            const int gi = (ok[u] ? wi : gw) * 4 + quad, mrow = gi / 6, hq = gi - mrow * 6, j = hq & 1;
            const float* ls = LSE + (size_t)mrow * 6;
            const float a0 = ls[j], a1 = ls[2 + j], a2 = ls[4 + j], mine = ls[hq];
            const float mx = fmaxf(a0, fmaxf(a1, a2));
            al[u] = __expf(mine - mx) / (__expf(a0 - mx) + __expf(a1 - mx) + __expf(a2 - mx));
            pp[u] = MIX + (size_t)mrow * DM + (10 + hq) * 128 + sub * 8;
            w[u] = *(const v4u*)pp[u];
        }
#pragma unroll
        for (int u = 0; u < U; ++u) { const float alpha = al[u];
            v4u o; o.x = pk2(bflo(w[u].x) * alpha, bfhi(w[u].x) * alpha); o.y = pk2(bflo(w[u].y) * alpha, bfhi(w[u].y) * alpha);
            o.z = pk2(bflo(w[u].z) * alpha, bfhi(w[u].z) * alpha); o.w = pk2(bflo(w[u].w) * alpha, bfhi(w[u].w) * alpha);
            if (ok[u]) *(v4u*)pp[u] = o; }
    }
}

#define XB_TMO      128
#define XB_XCNT(j)  (256  + 64 * (j))
#define XB_XSUB(j)  (1280 + 64 * (j))
#define XB_XGEN(j)  (2304 + 64 * (j))
#define XB_TOP      3328
#define XB_TOPGEN   3392
#define XCD_BAR_WORDS 3456
#define XB_SPIN_CAP (1u << 22)

__device__ __forceinline__ unsigned xb_ld(unsigned* p)              { return __hip_atomic_load(p, __ATOMIC_RELAXED, __HIP_MEMORY_SCOPE_AGENT); }
__device__ __forceinline__ unsigned xb_add(unsigned* p, unsigned v) { return __hip_atomic_fetch_add(p, v, __ATOMIC_RELAXED, __HIP_MEMORY_SCOPE_AGENT); }
__device__ __forceinline__ unsigned xb_xcc_id() { return (unsigned)__builtin_amdgcn_s_getreg((3 << 11) | 20) & 0xFu; }
#define XB_SPIN(cond, bar) do { unsigned _sp = 0; while (cond) { __builtin_amdgcn_s_sleep(1); \
    if ((++_sp & 255u) == 0u) { if (xb_ld(&(bar)[XB_TMO])) break; if (_sp > XB_SPIN_CAP) { atomicAdd(&(bar)[XB_TMO], 1u); break; } } } } while (0)

struct XcdBarrier {
    unsigned* bar; unsigned x;
    volatile LAS unsigned* st;
};

__device__ __forceinline__ XcdBarrier xcd_barrier_post(unsigned* bar, volatile LAS unsigned* st) {
    XcdBarrier b; b.bar = bar; b.x = xb_xcc_id(); b.st = st;
    if (threadIdx.x == 0) (void)xb_add(&bar[XB_XCNT(b.x)], 1u);
    return b;
}
__device__ __forceinline__ void xcd_barrier_complete(unsigned* bar, unsigned x, unsigned& nloc, unsigned& nx) {
    const unsigned G = gridDim.x * gridDim.y * gridDim.z;
    unsigned sum, cnt, mine, sp = 0u;
    for (;;) {
        sum = 0u; cnt = 0u; mine = 0u;
#pragma unroll
        for (unsigned j = 0; j < 16; ++j) { const unsigned c = xb_ld(&bar[XB_XCNT(j)]); sum += c; cnt += (c > 0u) ? 1u : 0u; mine = (j == x) ? c : mine; }
        if (sum == G) break;
        __builtin_amdgcn_s_sleep(1);
        if ((++sp & 255u) == 0u) { if (xb_ld(&bar[XB_TMO])) break; if (sp > XB_SPIN_CAP) { atomicAdd(&bar[XB_TMO], 1u); break; } }
    }
    nloc = mine > 0u ? mine : 1u; nx = cnt > 0u ? cnt : 1u;
}

__device__ __forceinline__ void xcd_barrier(const XcdBarrier& b) {
    asm volatile("s_waitcnt vmcnt(0)" ::: "memory");
    __syncthreads();
    if (threadIdx.x == 0) {
        unsigned* bar = b.bar;
        __builtin_amdgcn_s_waitcnt(0);
        unsigned nloc = b.st[0], nx = b.st[1];
        if (nloc == 0u) { xcd_barrier_complete(bar, b.x, nloc, nx); b.st[0] = nloc; b.st[1] = nx; }
        const unsigned old = xb_add(&bar[XB_XSUB(b.x)], 1u);
        const unsigned gen = old / nloc;
        if (old + 1u == (gen + 1u) * nloc) {
            __builtin_amdgcn_fence(__ATOMIC_RELEASE, "agent");
            asm volatile("s_waitcnt vmcnt(0)" ::: "memory");
            const unsigned og = xb_add(&bar[XB_TOP], 1u);
            const unsigned tg = og / nx;
            if (og + 1u == (tg + 1u) * nx) xb_add(&bar[XB_TOPGEN], 1u);
            else XB_SPIN(xb_ld(&bar[XB_TOPGEN]) == tg, bar);
            __builtin_amdgcn_fence(__ATOMIC_ACQUIRE, "agent");
            xb_add(&bar[XB_XGEN(b.x)], 1u);
            asm volatile("s_waitcnt vmcnt(0)" ::: "memory");
        } else {
            XB_SPIN(xb_ld(&bar[XB_XGEN(b.x)]) == gen, bar);
            __builtin_amdgcn_fence(__ATOMIC_ACQUIRE, "agent");
            asm volatile("s_waitcnt vmcnt(0)" ::: "memory");
        }
    }
    __syncthreads();
}

constexpr int N_PHASES = 19;
template <unsigned PM>
__global__ void __launch_bounds__(512, 2) fwd_kernel(Args args) {
    extern __shared__ __attribute__((aligned(16))) unsigned char lds_raw[];
    Frame F;
    F.lds = (LAS unsigned char*)lds_raw; F.tid = threadIdx.x; F.lane = F.tid & 63; F.wave = __builtin_amdgcn_readfirstlane(F.tid >> 6);
    F.G = gridDim.x; F.bid = blockIdx.x; F.a = &args; F.ws = args.ws;
    const int lo = args.ph_lo, hi = args.ph_hi;
    volatile LAS unsigned* bar_st = (volatile LAS unsigned*)(F.lds + LDS_BYTES - 64);
    if (F.tid < 16) bar_st[F.tid] = 0u;
    __syncthreads();
    XcdBarrier xbar; xbar.bar = (unsigned*)(F.ws + WS_CTL); xbar.x = 0; xbar.st = bar_st;
    if (hi - lo > 2) xbar = xcd_barrier_post((unsigned*)(F.ws + WS_CTL), bar_st);
#define IN(k) (lo <= (k) && (k) < hi)
#define HAS(bit) ((PM >> (bit)) & 1u)
#define OPAQUE_TID() do { int t_ = threadIdx.x; asm volatile("" : "+v"(t_)); F.tid = t_; F.lane = t_ & 63; int b_ = blockIdx.x; asm volatile("" : "+s"(b_)); F.bid = b_; } while (0)
#define SEAM(k) do { if (IN(k) && IN((k) + 1)) { if (lo < 0) cg::this_grid().sync(); else xcd_barrier(xbar); } } while (0)
    if constexpr (HAS(0)) { if (IN(0)) { for (int rep = 0; rep < PR_MISC; ++rep) { OPAQUE_TID(); prologue_phase(F); } } }
#pragma unroll 1
    for (int layer = 0; layer < 2; ++layer) {
        const int pb = 1 + 9 * layer;
        unsigned char* wl = F.ws + WS_W + (size_t)layer * W_LAYER;
        const float* xin = layer == 0 ? args.x : args.out;
        if constexpr (HAS(1)) if (IN(pb + 0)) { OPAQUE_TID(); rms_phase(F, xin, args.norm_attn + layer * DM, WSP(bf16, WS_H)); }
        SEAM(pb + 0);
        if constexpr (HAS(2)) if (IN(pb + 1)) { OPAQUE_TID(); pg8::Gemm g{WSP(bf16, WS_H), (const bf16*)(wl + W_IN), M, NP, DM}; pg8::StaticOrder S; S.init(M, NP, F.G, F.bid);
            EpiStoreBf16 E{WSP(bf16, WS_P), NP, args.qk_gain + (size_t)layer * 8 * 128, (LAS float*)(F.lds + 131072)}; for (int rep = 0; rep < PR_GEMM; ++rep) pg8::gemm_phase<EpiStoreBf16, pg8::StaticOrder, true, true>(F.lds, g, S, E); }
        SEAM(pb + 1);
        if constexpr (HAS(3)) if (IN(pb + 2)) { OPAQUE_TID(); for (int it = F.bid; it < 256; it += F.G) { OPAQUE_TID(); compress_item(F, layer, it); }
            if (F.G == 256) {
                const int xs = F.bid & 7, j = F.bid >> 3;
                for (int k = 0; k < 2; ++k) { const int mm = j + 32 * k, hb = (xs & 1) * 2 + (mm >> 5); OPAQUE_TID(); b_item(F, layer, (mm & 31) + 32 * hb + 128 * (xs >> 1)); }
                for (int k = 0; k < 2; ++k) { const int mm = j + 32 * k; OPAQUE_TID(); c_item(F, layer, (xs >> 2) * 256 + (mm >> 1) * 8 + (xs & 3) * 2 + (mm & 1)); }
                { const int mm = (xs & 1) * 32 + j; OPAQUE_TID(); c_item(F, layer, 2 * 256 + (mm >> 1) * 8 + (xs >> 1) * 2 + (mm & 1)); }
            } else {
                for (int it = F.bid; it < 512 + 768; it += F.G) { OPAQUE_TID(); if (it < 512) b_item(F, layer, it); else c_item(F, layer, it - 512); }
            } }
        SEAM(pb + 2);
        if constexpr (HAS(4)) if (IN(pb + 3)) { OPAQUE_TID(); for (int it = F.bid; it < 256; it += F.G) { OPAQUE_TID(); cmp_item(F, layer, (it & 7) * 32 + (it >> 3)); } }
        SEAM(pb + 3);
        if constexpr (HAS(5)) if (IN(pb + 4)) { OPAQUE_TID();
            if (F.G == 256) {
                const int xs = F.bid & 7, j = F.bid >> 3, base = (xs >> 1) * 6 + (xs & 1) * 3;
                a_item32(F, layer, (j / 3) * 24 + base + j % 3); OPAQUE_TID();
                if (j >= 16) { const int k2 = 63 - j; a_item32(F, layer, (k2 / 3) * 24 + base + k2 % 3); OPAQUE_TID(); } }
            else { for (int it = F.bid; it < 384; it += F.G) { OPAQUE_TID(); a_item32(F, layer, it); } OPAQUE_TID(); }
            ccombine_phase(F); }
        SEAM(pb + 4);
        if constexpr (HAS(6)) if (IN(pb + 5)) { OPAQUE_TID(); pg8::Gemm g{WSP(bf16, WS_MIX), (const bf16*)(wl + W_OUT), M, DM, DM}; pg8::StaticOrder S; S.init(M, DM, F.G, F.bid);
            EpiResidF32 E{xin, args.out, DM}; pg8::gemm_phase<EpiResidF32, pg8::StaticOrder, true, true>(F.lds, g, S, E); }
        SEAM(pb + 5);
        if constexpr (HAS(7)) if (IN(pb + 6)) { OPAQUE_TID(); rms_phase(F, args.out, args.norm_ffn + layer * DM, WSP(bf16, WS_H)); }
        SEAM(pb + 6);
        if constexpr (HAS(8)) if (IN(pb + 7)) { OPAQUE_TID(); pg8::Gemm g{WSP(bf16, WS_H), (const bf16*)(wl + W_GU), M, 2 * FF, DM}; pg8::StaticOrder S; S.init(M, 2 * FF, F.G, F.bid);
            EpiSwiGLU E{WSP(bf16, WS_P), FF}; for (int rep = 0; rep < PR_GEMM; ++rep) pg8::gemm_phase<EpiSwiGLU, pg8::StaticOrder, true, true>(F.lds, g, S, E); }
        SEAM(pb + 7);
        if constexpr (HAS(9)) if (IN(pb + 8)) { OPAQUE_TID(); pg8::Gemm g{WSP(bf16, WS_P), (const bf16*)(wl + W_D), M, DM, FF}; pg8::StaticOrder S; S.init(M, DM, F.G, F.bid);
            EpiResidF32 E{args.out, args.out, DM}; pg8::gemm_phase<EpiResidF32, pg8::StaticOrder, true, true>(F.lds, g, S, E); }
        SEAM(pb + 8);
    }
#undef IN
#undef SEAM
}

extern "C" void kernel_launch(void* const* d_in, const int* in_sizes, int n_in, void* d_out, int out_size, void* d_ws, size_t ws_size, hipStream_t stream) {
    static int grid = 0;
    if (grid == 0) {
        if (n_in != 14 || ws_size < WS_END) { fprintf(stderr, "kernel_launch: unexpected n_in %d / ws_size %zu (need %zu)\n", n_in, ws_size, (size_t)WS_END); grid = -1; return; }
        int dev = 0, cus = 0, per_cu = 0;
        (void)hipGetDevice(&dev); (void)hipDeviceGetAttribute(&cus, hipDeviceAttributeMultiprocessorCount, dev);
#if MK_ONE_LAUNCH
        if (hipFuncSetAttribute((const void*)fwd_kernel<0x3ffu>, hipFuncAttributeMaxDynamicSharedMemorySize, LDS_BYTES) != hipSuccess) { fprintf(stderr, "kernel_launch: hipFuncSetAttribute failed\n"); grid = -1; return; }
        (void)hipOccupancyMaxActiveBlocksPerMultiprocessor(&per_cu, (const void*)fwd_kernel<0x3ffu>, 512, LDS_BYTES);
#else
#define SETATTR_K(kk) if (hipFuncSetAttribute((const void*)fwd_kernel<(1u << kk)>, hipFuncAttributeMaxDynamicSharedMemorySize, LDS_BYTES) != hipSuccess) { fprintf(stderr, "kernel_launch: hipFuncSetAttribute failed\n"); grid = -1; return; }
        SETATTR_K(0) SETATTR_K(1) SETATTR_K(2) SETATTR_K(3) SETATTR_K(4) SETATTR_K(5) SETATTR_K(6) SETATTR_K(7) SETATTR_K(8) SETATTR_K(9)
#undef SETATTR_K
        per_cu = 1;
#endif
        (void)hipGetLastError();
        if (per_cu < 1) per_cu = 1;
        grid = cus * per_cu;
    }
    if (grid < 0) return;
    Args a{};
    a.x = (const float*)d_in[0]; a.norm_attn = (const float*)d_in[1]; a.w_in = (const float*)d_in[2]; a.qk_gain = (const float*)d_in[3];
    a.cmp_pe = (const float*)d_in[4]; a.cmp_w1 = (const float*)d_in[5]; a.cmp_w2 = (const float*)d_in[6]; a.sinks = (const float*)d_in[7];
    a.rel_bias = (const float*)d_in[8]; a.w_out = (const float*)d_in[9]; a.norm_ffn = (const float*)d_in[10]; a.w_gate = (const float*)d_in[11];
    a.w_up = (const float*)d_in[12]; a.w_down = (const float*)d_in[13]; a.out = (float*)d_out; a.ws = (unsigned char*)d_ws;
#if MK_ONE_LAUNCH
    if (hipMemsetAsync((char*)d_ws + WS_CTL, 0, CTL_BYTES, stream) != hipSuccess) { fprintf(stderr, "kernel_launch: memset of the barrier words failed\n"); return; }
    a.ph_lo = 0; a.ph_hi = N_PHASES;
    void* kargs[] = {&a};
    hipError_t e = hipLaunchCooperativeKernel((const void*)fwd_kernel<0x3ffu>, dim3(grid), dim3(512), kargs, LDS_BYTES, stream);
    if (e != hipSuccess) fprintf(stderr, "cooperative launch failed: %s (grid %d)\n", hipGetErrorString(e), grid);
#else
    for (int p = 0; p < N_PHASES; ++p) {
        a.ph_lo = p; a.ph_hi = p + 1;
        const int k = p == 0 ? 0 : 1 + (p - 1) % 9;
        switch (k) {
#define LAUNCH_K(kk) case kk: hipLaunchKernelGGL(fwd_kernel<(1u << kk)>, dim3(grid), dim3(512), LDS_BYTES, stream, a); break;
            LAUNCH_K(0) LAUNCH_K(1) LAUNCH_K(2) LAUNCH_K(3) LAUNCH_K(4) LAUNCH_K(5) LAUNCH_K(6) LAUNCH_K(7) LAUNCH_K(8) LAUNCH_K(9)
#undef LAUNCH_K
        }
    }
#endif
}
```
